# Optimizing an MI355X kernel written in HIP

```python
import math
import jax
import jax.numpy as jnp
from jax import lax
import numpy as np


D_MODEL = 2048
BATCH = 2
SEQ = 16384
DEPTH = 4

GRID_W = 64
CTX_LEN = 256
N_MIXERS = 3
N_HYENA = len(range(0, DEPTH, N_MIXERS))
N_MLA = len(range(1, DEPTH, N_MIXERS))
N_POOL = len(range(2, DEPTH, N_MIXERS))

D_FF = -(-(8 * D_MODEL) // (3 * 256)) * 256

ALPHA = (2.0 * DEPTH) ** 0.25
BETA = (8.0 * DEPTH) ** -0.25
LN_EPS = 1e-6
RMS_EPS = 1e-6

HY_EMB = 33
HY_BANDS = (HY_EMB - 1) // 2
HY_FILT = 64
HY_TARGET = 1e-2
HY_FAST = 0.3
HY_SLOW = 1.5
HY_MIN_DECAY = math.log(HY_TARGET) / HY_SLOW
HY_MAX_DECAY = math.log(HY_TARGET) / HY_FAST

MLA_HEADS = D_MODEL // 128
QK_NOPE = 128
QK_ROPE = 64
V_HEAD = 128
Q_RANK = D_MODEL // 4
KV_RANK = D_MODEL // 4
ROPE_PAIRS = QK_ROPE // 4
ROPE_THETA = 10000.0
Q_BLOCK = 128
ATTN_SCALE = (QK_NOPE + QK_ROPE) ** -0.5

POOL_WINDOWS = (2, 4, 8, 16)
POOL_GROUPS = len(POOL_WINDOWS)
POOL_CH = D_MODEL // POOL_GROUPS

kernel_name = 'hybrid_dit_hyena_mla_pool'


def layer_norm(x, g, b):
    xf = x.astype(jnp.float32)
    mu = jnp.mean(xf, axis=-1, keepdims=True)
    var = jnp.mean(jnp.square(xf - mu), axis=-1, keepdims=True)
    return ((xf - mu) * lax.rsqrt(var + LN_EPS) * g + b).astype(x.dtype)


def rms_norm(x, g):
    xf = x.astype(jnp.float32)
    return (xf * lax.rsqrt(jnp.mean(jnp.square(xf), axis=-1, keepdims=True) + RMS_EPS) * g).astype(x.dtype)


def modulate(x, shift, scale):
    return x * (1 + scale) + shift


def post_norm(x, y, g, b):
    return layer_norm(ALPHA * x + y, g, b)


def swiglu(u, w_gate, w_up, w_down):
    return (jax.nn.silu(u @ w_gate) * (u @ w_up)) @ w_down


def axial_rope_tables(L):
    rows = L // GRID_W
    row = jnp.repeat(jnp.arange(rows, dtype=jnp.float32), GRID_W)
    col = jnp.tile(jnp.arange(GRID_W, dtype=jnp.float32), rows)
    inv = ROPE_THETA ** (-jnp.arange(ROPE_PAIRS, dtype=jnp.float32) / ROPE_PAIRS)
    ang = jnp.stack([row[:, None] * inv, col[:, None] * inv], axis=1)
    ang = jnp.broadcast_to(ang[:, :, None, :], (L, 2, 2, ROPE_PAIRS)).reshape(L, QK_ROPE)
    return jnp.cos(ang), jnp.sin(ang)


def apply_axial_rope(x, cos, sin):
    xs = x.reshape(x.shape[:-1] + (2, 2, ROPE_PAIRS))
    rot = jnp.stack([-xs[..., 1, :], xs[..., 0, :]], axis=-2).reshape(x.shape)
    return (x * cos + rot * sin).astype(x.dtype)


def short_conv3(u, w, b):
    L = u.shape[1]
    up = jnp.pad(u, ((0, 0), (1, 1), (0, 0)))
    return up[:, :L] * w[0] + up[:, 1:L + 1] * w[1] + up[:, 2:] * w[2] + b


def implicit_filter(L, f_w_in, f_w_hid, f_b, f_freq, f_w_out):
    f32 = jnp.float32
    pos = jnp.arange(L, dtype=f32)
    t = pos / (L - 1)
    bands = jnp.linspace(1e-4, HY_BANDS - 1, HY_BANDS, dtype=f32)
    ang = (2.0 * math.pi / L) * pos[:, None] * bands[None, :]
    z = jnp.concatenate([t[:, None], jnp.cos(ang), -jnp.sin(ang)], axis=-1)
    f_w_in, f_w_hid, f_b, f_freq, f_w_out = [a.astype(f32) for a in (f_w_in, f_w_hid, f_b, f_freq, f_w_out)]
    g = jnp.sin(f_freq[0] * (z @ f_w_in + f_b[0]))
    g = jnp.sin(f_freq[1] * (g @ f_w_hid[0] + f_b[1]))
    g = jnp.sin(f_freq[2] * (g @ f_w_hid[1] + f_b[2]))
    filt = g @ f_w_out
    dist = jnp.abs(pos - L // 2) / (L // 2)
    deltas = jnp.abs(jnp.linspace(HY_MIN_DECAY, HY_MAX_DECAY, filt.shape[-1], dtype=f32))
    filt = filt * jnp.exp(-dist[:, None] * deltas[None, :])
    return filt / jnp.sum(jnp.abs(filt), axis=0, keepdims=True)


def centred_long_conv(u, h):
    L = u.shape[1]
    n = 2 * L
    U = jnp.fft.rfft(u.astype(jnp.float32), n=n, axis=1)
    H = jnp.fft.rfft(h.astype(jnp.float32), n=n, axis=0)
    y = jnp.fft.irfft(U * H[None], n=n, axis=1)[:, L // 2:L // 2 + L]
    return y.astype(u.dtype)


def hyena_mixer(u, w_in, b_in, conv_w, conv_b, f_w_in, f_w_hid, f_b, f_freq, f_w_out, bias, w_out, b_out):
    L = u.shape[1]
    proj = short_conv3(u @ w_in + b_in, conv_w, conv_b)
    x0, x1, v = jnp.split(proj, 3, axis=-1)
    h = implicit_filter(L, f_w_in, f_w_hid, f_b, f_freq, f_w_out)
    v = v * x1
    y = x0 * (centred_long_conv(v, h) + v * bias)
    return y @ w_out + b_out


def mla_queries(cq, q_norm, wq_b, cos, sin):
    B, L, _ = cq.shape
    q = (rms_norm(cq, q_norm) @ wq_b).reshape(B, L, MLA_HEADS, QK_NOPE + QK_ROPE)
    q_nope, q_rope = q[..., :QK_NOPE], q[..., QK_NOPE:]
    if cos is not None:
        q_rope = apply_axial_rope(q_rope, cos[None, :, None], sin[None, :, None])
    return q_nope, q_rope


def mla_keys_values(ckv, k_rope, kv_norm, wkv_b, cos, sin):
    B, L, _ = ckv.shape
    kv = (rms_norm(ckv, kv_norm) @ wkv_b).reshape(B, L, MLA_HEADS, QK_NOPE + V_HEAD)
    k_nope, v = kv[..., :QK_NOPE], kv[..., QK_NOPE:]
    if cos is not None:
        k_rope = apply_axial_rope(k_rope, cos[None], sin[None])
    return k_nope, k_rope, v


def mla_attend(q_nope, q_rope, k_nope, k_rope, v):
    B, Lq = q_nope.shape[:2]
    nb = Lq // Q_BLOCK
    qn = q_nope.reshape(B, nb, Q_BLOCK, MLA_HEADS, QK_NOPE).transpose(1, 0, 2, 3, 4)
    qr = q_rope.reshape(B, nb, Q_BLOCK, MLA_HEADS, QK_ROPE).transpose(1, 0, 2, 3, 4)

    def block(args):
        qn_b, qr_b = args
        s = jnp.einsum('bqhd,bkhd->bhqk', qn_b, k_nope) + jnp.einsum('bqhr,bkr->bhqk', qr_b, k_rope)
        p = jax.nn.softmax(s.astype(jnp.float32) * ATTN_SCALE, axis=-1).astype(v.dtype)
        return jnp.einsum('bhqk,bkhd->bqhd', p, v)

    o = lax.map(block, (qn, qr))
    return o.transpose(1, 0, 2, 3, 4).reshape(B, Lq, MLA_HEADS * V_HEAD)


def pool_mixer(u, w_grp, scale):
    B, L, D = u.shape
    uf = u.astype(jnp.float32).reshape(B, L, POOL_GROUPS, POOL_CH)
    cs = jnp.concatenate([jnp.zeros((B, 1, POOL_GROUPS, POOL_CH), jnp.float32), jnp.cumsum(uf, axis=1)], axis=1)
    t = jnp.arange(L)
    outs = []
    for g, w in enumerate(POOL_WINDOWS):
        lo = jnp.clip(t - w // 2, 0, L)
        hi = jnp.clip(t + w // 2, 0, L)
        csg = cs[:, :, g]
        s = jnp.take(csg, hi, axis=1) - jnp.take(csg, lo, axis=1)
        mean = s / (hi - lo).astype(jnp.float32)[None, :, None]
        outs.append(mean - uf[:, :, g])
    d = jnp.stack(outs, axis=2).astype(u.dtype)
    y = jnp.einsum('blgc,gce->blge', d, w_grp).reshape(B, L, D)
    return y * scale


def setup_inputs(seed: int = 0) -> dict:
    key = jax.random.key(seed)
    ks = iter(jax.random.split(key, 40))

    def nrm(shape, s):
        return jax.random.normal(next(ks), shape, jnp.float32) * s

    D = D_MODEL
    inp = {}
    inp['x'] = nrm((BATCH, SEQ, D), 1.0)
    inp['c'] = nrm((BATCH, D), 1.0)
    inp['ctx'] = nrm((BATCH, CTX_LEN, D), 1.0)
    inp['c_ctx'] = nrm((D,), 1.0)
    inp['ada_w'] = nrm((DEPTH, D, 6 * D), 0.5 * D ** -0.5)
    inp['ada_b'] = nrm((DEPTH, 6 * D), 0.02)
    inp['ln_g'] = 1.0 + nrm((DEPTH, 2, D), 0.02)
    inp['ln_b'] = nrm((DEPTH, 2, D), 0.02)
    inp['ffn_w_gate'] = nrm((DEPTH, D, D_FF), D ** -0.5)
    inp['ffn_w_up'] = nrm((DEPTH, D, D_FF), D ** -0.5)
    inp['ffn_w_down'] = nrm((DEPTH, D_FF, D), BETA * D_FF ** -0.5)
    inp['hy_w_in'] = nrm((N_HYENA, D, 3 * D), D ** -0.5)
    inp['hy_b_in'] = nrm((N_HYENA, 3 * D), 0.02)
    inp['hy_conv_w'] = nrm((N_HYENA, 3, 3 * D), 3 ** -0.5)
    inp['hy_conv_b'] = nrm((N_HYENA, 3 * D), 0.02)
    inp['hy_f_w_in'] = nrm((N_HYENA, HY_EMB, HY_FILT), HY_EMB ** -0.5)
    inp['hy_f_w_hid'] = nrm((N_HYENA, 2, HY_FILT, HY_FILT), HY_FILT ** -0.5)
    inp['hy_f_b'] = nrm((N_HYENA, 3, HY_FILT), 0.02)
    inp['hy_f_freq'] = 1.0 + nrm((N_HYENA, 3, HY_FILT), 0.1)
    inp['hy_f_w_out'] = nrm((N_HYENA, HY_FILT, D), HY_FILT ** -0.5)
    inp['hy_bias'] = nrm((N_HYENA, D), 1.0)
    inp['hy_w_out'] = nrm((N_HYENA, D, D), BETA * D ** -0.5)
    inp['hy_b_out'] = nrm((N_HYENA, D), 0.02)
    inp['mla_w_in'] = nrm((N_MLA, D, Q_RANK + KV_RANK + QK_ROPE), D ** -0.5)
    inp['mla_q_norm'] = 1.0 + nrm((N_MLA, Q_RANK), 0.02)
    inp['mla_kv_norm'] = 1.0 + nrm((N_MLA, KV_RANK), 0.02)
    inp['mla_wq_b'] = nrm((N_MLA, Q_RANK, MLA_HEADS * (QK_NOPE + QK_ROPE)), Q_RANK ** -0.5)
    inp['mla_wkv_b'] = nrm((N_MLA, KV_RANK, MLA_HEADS * (QK_NOPE + V_HEAD)), KV_RANK ** -0.5)
    inp['mla_w_out'] = nrm((N_MLA, MLA_HEADS * V_HEAD, D), BETA * (MLA_HEADS * V_HEAD) ** -0.5)
    inp['pool_w'] = nrm((N_POOL, POOL_GROUPS, POOL_CH, POOL_CH), BETA * POOL_CH ** -0.5)
    inp['pool_scale'] = 1.0 + nrm((N_POOL, D), 0.1)
    return inp


def reference(x, c, ctx, c_ctx, ada_w, ada_b, ln_g, ln_b, ffn_w_gate, ffn_w_up, ffn_w_down,
              hy_w_in, hy_b_in, hy_conv_w, hy_conv_b, hy_f_w_in, hy_f_w_hid, hy_f_b, hy_f_freq,
              hy_f_w_out, hy_bias, hy_w_out, hy_b_out,
              mla_w_in, mla_q_norm, mla_kv_norm, mla_wq_b, mla_wkv_b, mla_w_out,
              pool_w, pool_scale):
    L = x.shape[1]
    cos, sin = axial_rope_tables(L)
    mla_layers = [i for i in range(DEPTH) if i % N_MIXERS == 1]
    last_ctx_read = mla_layers[-1] if mla_layers else -1
    silu_c = jax.nn.silu(c)
    silu_cc = jax.nn.silu(c_ctx)
    h, hc = x, ctx
    for i in range(DEPTH):
        kind, j = i % N_MIXERS, i // N_MIXERS
        ctx_update = i < last_ctx_read
        sh1, sc1, g1, sh2, sc2, g2 = [t[:, None, :] for t in jnp.split(silu_c @ ada_w[i] + ada_b[i], 6, axis=-1)]
        if kind == 1 or ctx_update:
            csh1, csc1, cg1, csh2, csc2, cg2 = jnp.split(silu_cc @ ada_w[i] + ada_b[i], 6, axis=-1)
            uc = modulate(hc, csh1, csc1)
        u = modulate(h, sh1, sc1)
        if kind == 0:
            hy = (hy_w_in[j], hy_b_in[j], hy_conv_w[j], hy_conv_b[j], hy_f_w_in[j], hy_f_w_hid[j],
                  hy_f_b[j], hy_f_freq[j], hy_f_w_out[j], hy_bias[j], hy_w_out[j], hy_b_out[j])
            y = hyena_mixer(u, *hy)
            if ctx_update:
                yc = hyena_mixer(uc, *hy)
        elif kind == 1:
            w_in = mla_w_in[j]
            if ctx_update:
                cq_c, ckv_c, kr_c = jnp.split(uc @ w_in, [Q_RANK, Q_RANK + KV_RANK], axis=-1)
            else:
                ckv_c, kr_c = jnp.split(uc @ w_in[:, Q_RANK:], [KV_RANK], axis=-1)
            kn_c, kr_c, v_c = mla_keys_values(ckv_c, kr_c, mla_kv_norm[j], mla_wkv_b[j], None, None)
            cq, ckv, kr = jnp.split(u @ w_in, [Q_RANK, Q_RANK + KV_RANK], axis=-1)
            qn, qr = mla_queries(cq, mla_q_norm[j], mla_wq_b[j], cos, sin)
            kn, kr, v = mla_keys_values(ckv, kr, mla_kv_norm[j], mla_wkv_b[j], cos, sin)
            o = mla_attend(qn, qr, jnp.concatenate([kn, kn_c], axis=1),
                           jnp.concatenate([kr, kr_c], axis=1), jnp.concatenate([v, v_c], axis=1))
            y = o @ mla_w_out[j]
            if ctx_update:
                qn_c, qr_c = mla_queries(cq_c, mla_q_norm[j], mla_wq_b[j], None, None)
                yc = mla_attend(qn_c, qr_c, kn_c, kr_c, v_c) @ mla_w_out[j]
        else:
            y = pool_mixer(u, pool_w[j], pool_scale[j])
            if ctx_update:
                yc = pool_mixer(uc, pool_w[j], pool_scale[j])
        ffn = (ffn_w_gate[i], ffn_w_up[i], ffn_w_down[i])
        h = post_norm(h, g1 * y, ln_g[i, 0], ln_b[i, 0])
        h = post_norm(h, g2 * swiglu(modulate(h, sh2, sc2), *ffn), ln_g[i, 1], ln_b[i, 1])
        if ctx_update:
            hc = post_norm(hc, cg1 * yc, ln_g[i, 0], ln_b[i, 0])
            hc = post_norm(hc, cg2 * swiglu(modulate(hc, csh2, csc2), *ffn), ln_g[i, 1], ln_b[i, 1])
    return h
```

```cpp
#include <hip/hip_runtime.h>
#define MK_SINGLE 1
#include <cstdio>
#include <cstdint>

constexpr int D = 2048, DFF = 5632, SEQ = 16384, CTXL = 256, NBATCH = 2;
constexpr int TB = SEQ + CTXL;
constexpr int TM = NBATCH * TB;
constexpr float ALPHA = 1.681792830507429f;
constexpr float LN_EPS = 1e-6f, RMS_EPS = 1e-6f;
constexpr int MODW = 6 * D;

#define GAS __attribute__((address_space(1)))
#define LAS __attribute__((address_space(3)))
typedef unsigned short bf16_t;
typedef short bf16x8 __attribute__((ext_vector_type(8)));
typedef float f32x4 __attribute__((ext_vector_type(4)));
typedef float f32x2 __attribute__((ext_vector_type(2)));
typedef unsigned u32x4 __attribute__((ext_vector_type(4)));
typedef unsigned u32x2 __attribute__((ext_vector_type(2)));

__device__ __forceinline__ float bf2f(bf16_t v) { return __uint_as_float(((unsigned)v) << 16); }
__device__ __forceinline__ unsigned cvt_pk_bf16(float lo, float hi) { unsigned r; asm volatile("v_cvt_pk_bf16_f32 %0, %1, %2" : "=v"(r) : "v"(lo), "v"(hi)); return r; }
__device__ __forceinline__ bf16_t f2bf(float f) { return (bf16_t)(cvt_pk_bf16(f, 0.f) & 0xffffu); }
__device__ __forceinline__ float silu_f(float x) { return x * __builtin_amdgcn_rcpf(1.0f + __expf(-x)); }
__device__ __forceinline__ float wave_sum(float v) {
#pragma unroll
    for (int o = 1; o < 64; o <<= 1) v += __shfl_xor(v, o);
    return v;
}

namespace pg8 {
constexpr int BM = 256, BK = 64, HALF = 128, HTB = HALF * BK * 2  , STAGE_BYTES = 8 * HTB, NXCD = 8, WGM = 8;
__host__ __device__ __forceinline__ int lds_byte(int r, int c) { const int st = (r >> 4) * 2 + (c >> 5), rr = r & 15, cc = c & 31, ob = rr * 64 + cc * 2; return st * 1024 + (ob ^ (((ob >> 9) & 1) << 5)); }
__host__ __device__ __forceinline__ void stage_rc(int b, int& R, int& C) { const int st = b / 1024, sb = b % 1024, swz = sb ^ (((sb >> 9) & 1) << 5); R = (st >> 1) * 16 + swz / 64; C = (st & 1) * 32 + (swz % 64) / 2; }
__host__ __device__ __forceinline__ int perm32(int rho) { const int n = rho >> 4, i = rho & 15; return 8 * (i >> 2) + 4 * n + (i & 3); }

struct Unit { int pm, pn; };
struct Gemm { const bf16_t* A; const bf16_t* Bt; int lda, ldb, K; };

struct Order {
    int nM, nN, nwg, G, c, skipM, skipN, grp, ks, nNr, mmul, kbytes;
    __device__ __forceinline__ void init(int nM_, int nN_, int G_, int c_, int skipM_, int skipN_, int grp_) { nM = nM_; nN = nN_; nwg = nM * nN; G = G_; c = c_; skipM = skipM_; skipN = skipN_; grp = grp_; ks = 1; nNr = nN_; mmul = 1; kbytes = 0; }
    __device__ __forceinline__ void init_splitk(int nM_, int nNr_, int ks_, int kslice, int mmul_, int G_, int c_) { init(nM_, nNr_ * ks_, G_, c_, 0, 0, 0); ks = ks_; nNr = nNr_; mmul = mmul_; kbytes = kslice * 2; }
    __device__ __forceinline__ size_t a_byte(const Unit& u, size_t tstepA) const { return (size_t)(u.pm * mmul) * tstepA + a_off(u) + (ks > 1 ? (size_t)(u.pn / nNr) * (size_t)kbytes : 0u); }
    __device__ __forceinline__ size_t b_byte(const Unit& u, size_t tstepB) const { return ks > 1 ? (size_t)(u.pn % nNr) * tstepB + (size_t)(u.pn / nNr) * (size_t)kbytes : (size_t)u.pn * tstepB; }
    __device__ __forceinline__ bool next(int i, Unit& u) const {
        const long L = (long)i * G + c; if (L >= nwg) return false;
        int wgid = (int)L; { const int q = nwg / NXCD, r = nwg % NXCD, xcd = wgid % NXCD, off = wgid / NXCD; wgid = (xcd < r ? xcd * (q + 1) : r * (q + 1) + (xcd - r) * q) + off; }
        const int nig = WGM * nN, gid = wgid / nig, fm = gid * WGM, gsz = (nM - fm) < WGM ? (nM - fm) : WGM;
        u.pm = fm + ((wgid % nig) % gsz); u.pn = (wgid % nig) / gsz;
        if (skipM && u.pm >= 64) u.pm += 1;
        if (skipN && u.pn >= 64) u.pn += 1;
        return true;
    }
    __device__ __forceinline__ size_t a_off(const Unit& u) const { return grp ? (size_t)(u.pn >> 1) * 1024u : 0u; }
};

struct EpiPlain {
    static constexpr bool PERM = true;
    bf16_t* O; int ldc; const float* bias; const float* scale;
    __device__ __forceinline__ void operator()(const f32x4 (&acc)[2][2][4][2], const Unit& u, int wr, int wc, int fr, int fq) const {
        const int row0 = u.pm * BM + wr * 64 + fr, col0 = u.pn * BM + wc * 32 + 8 * fq;
        f32x4 bv[2][2], sv[2][2];
#pragma unroll
        for (int bj = 0; bj < 2; ++bj)
#pragma unroll
            for (int n = 0; n < 2; ++n) { bv[bj][n] = bias ? *(const f32x4*)(bias + col0 + bj * HALF + 4 * n) : (f32x4){0.f, 0.f, 0.f, 0.f};
                                          sv[bj][n] = scale ? *(const f32x4*)(scale + col0 + bj * HALF + 4 * n) : (f32x4){1.f, 1.f, 1.f, 1.f}; }
#pragma unroll
        for (int ai = 0; ai < 2; ++ai)
#pragma unroll
            for (int m = 0; m < 4; ++m) { bf16_t* rowp = O + (size_t)(row0 + ai * HALF + m * 16) * ldc + col0;
#pragma unroll
                for (int bj = 0; bj < 2; ++bj) { const f32x4 v0 = (acc[ai][bj][m][0] + bv[bj][0]) * sv[bj][0], v1 = (acc[ai][bj][m][1] + bv[bj][1]) * sv[bj][1];
                    u32x4 w; w.x = cvt_pk_bf16(v0[0], v0[1]); w.y = cvt_pk_bf16(v0[2], v0[3]); w.z = cvt_pk_bf16(v1[0], v1[1]); w.w = cvt_pk_bf16(v1[2], v1[3]);
                    *(u32x4*)(rowp + bj * HALF) = w; } }
    }
};
struct EpiSwiglu {
    static constexpr bool PERM = true;
    bf16_t* O; int ldc;
    static __device__ __forceinline__ float sw(float g, float u) { return (g * u) * __builtin_amdgcn_rcpf(1.0f + __builtin_amdgcn_exp2f(g)); }
    __device__ __forceinline__ void operator()(const f32x4 (&acc)[2][2][4][2], const Unit& u, int wr, int wc, int fr, int fq) const {
        const int row0 = u.pm * BM + wr * 64 + fr, col0 = u.pn * HALF + wc * 32 + 8 * fq;
#pragma unroll
        for (int ai = 0; ai < 2; ++ai)
#pragma unroll
            for (int m = 0; m < 4; ++m) { bf16_t* rowp = O + (size_t)(row0 + ai * HALF + m * 16) * ldc + col0;
                const f32x4 g0 = acc[ai][0][m][0], g1 = acc[ai][0][m][1], u0 = acc[ai][1][m][0], u1 = acc[ai][1][m][1];
                u32x4 w;
                w.x = cvt_pk_bf16(sw(g0[0], u0[0]), sw(g0[1], u0[1])); w.y = cvt_pk_bf16(sw(g0[2], u0[2]), sw(g0[3], u0[3]));
                w.z = cvt_pk_bf16(sw(g1[0], u1[0]), sw(g1[1], u1[1])); w.w = cvt_pk_bf16(sw(g1[2], u1[2]), sw(g1[3], u1[3]));
                *(u32x4*)rowp = w; }
    }
};
struct EpiQRope {
    static constexpr bool PERM = false;
    bf16_t* O; int ldc; const float* rope; float qscale;
    __device__ __forceinline__ void operator()(const f32x4 (&acc)[2][2][4][2], const Unit& u, int wr, int wc, int fr, int fq) const {
        const int row0 = u.pm * BM + wr * 64 + fr, col0 = u.pn * BM + wc * 32 + 4 * fq;
#pragma unroll
        for (int ai = 0; ai < 2; ++ai)
#pragma unroll
            for (int m = 0; m < 4; ++m) { const int row = row0 + ai * HALF + m * 16; const int t = row % TB; const int prow = (t >> 6) & 255, pcol = t & 63;
                bf16_t* rowp = O + (size_t)row * ldc + col0;
#pragma unroll
                for (int bj = 0; bj < 2; ++bj) { const int G = 8 * u.pn + 4 * bj + wc, gm = G % 6;
                    f32x4 x0 = acc[ai][bj][m][0], x1 = acc[ai][bj][m][1];
                    if (gm >= 4) { const int pos = (gm == 4) ? prow : pcol; const float* cs = rope + (size_t)(pos * 16 + 4 * fq) * 2;
                        const f32x4 c01 = *(const f32x4*)cs, c23 = *(const f32x4*)(cs + 4);
                        f32x4 o0, o1;
                        o0[0] = x0[0] * c01[0] - x1[0] * c01[1]; o1[0] = x1[0] * c01[0] + x0[0] * c01[1];
                        o0[1] = x0[1] * c01[2] - x1[1] * c01[3]; o1[1] = x1[1] * c01[2] + x0[1] * c01[3];
                        o0[2] = x0[2] * c23[0] - x1[2] * c23[1]; o1[2] = x1[2] * c23[0] + x0[2] * c23[1];
                        o0[3] = x0[3] * c23[2] - x1[3] * c23[3]; o1[3] = x1[3] * c23[2] + x0[3] * c23[3];
                        x0 = o0; x1 = o1; }
                    x0 *= qscale; x1 *= qscale;
                    u32x2 w0, w1; w0.x = cvt_pk_bf16(x0[0], x0[1]); w0.y = cvt_pk_bf16(x0[2], x0[3]); w1.x = cvt_pk_bf16(x1[0], x1[1]); w1.y = cvt_pk_bf16(x1[2], x1[3]);
                    *(u32x2*)(rowp + bj * HALF) = w0; *(u32x2*)(rowp + bj * HALF + 16) = w1; } }
    }
};

template <class Epi, bool ALIGN_EPI = true>
__device__ __forceinline__ void gemm_phase(LAS unsigned char* lds, const Gemm g, const Order& S, const Epi& E) {
    const int tid = threadIdx.x, wid = __builtin_amdgcn_readfirstlane(tid >> 6), lane = tid & 63, wr = wid >> 2, wc = wid & 3, fr = lane & 15, fq = lane >> 4;
    const int K = g.K, nt = K / BK;
    unsigned voffA[2], voffB[2];
#pragma unroll
    for (int i = 0; i < 2; ++i) { int R, C; stage_rc(tid * 16 + i * 8192, R, C); const int Rb = Epi::PERM ? ((R & ~31) + perm32(R & 31)) : R;
        voffA[i] = (unsigned)(R * g.lda + C) * 2u; voffB[i] = (unsigned)(Rb * g.ldb + C) * 2u; }
    const size_t kstep = (size_t)(BK * 2);
    const size_t hstepA = (size_t)HALF * g.lda * 2, hstepB = (size_t)HALF * g.ldb * 2;
    const size_t tstepA = 2 * hstepA, tstepB = 2 * hstepB;
    const unsigned ldsw = (unsigned)wid * 1024u;
    const int aoff = lds_byte(wr * 64 + fr, fq * 8), boff = lds_byte(wc * 32 + fr, fq * 8);
#define PG8_SA(b, h) (((b) * 2 + (h)) * HTB)
#define PG8_SB(b, h) ((4 + (b) * 2 + (h)) * HTB)
#define PG8_STAGE(bufoff, gbase, voff) do { _Pragma("unroll") for (int _i = 0; _i < 2; ++_i) \
        __builtin_amdgcn_global_load_lds((const unsigned*)((const char*)(gbase) + (voff)[_i]), (LAS unsigned*)(lds + (bufoff) + ldsw + _i * 8192), 16, 0, 0); } while (0)
#define PG8_LDA(dst, b, h) do { _Pragma("unroll") for (int m = 0; m < 4; ++m) _Pragma("unroll") for (int k = 0; k < 2; ++k) dst[m][k] = *(const LAS bf16x8*)(lds + PG8_SA(b, h) + aoff + m * 2048 + k * 1024); } while (0)
#define PG8_LDB(dst, b, h) do { _Pragma("unroll") for (int n = 0; n < 2; ++n) _Pragma("unroll") for (int k = 0; k < 2; ++k) dst[n][k] = *(const LAS bf16x8*)(lds + PG8_SB(b, h) + boff + n * 2048 + k * 1024); } while (0)
#define PG8_MMA(ai, bj, At, Bt) do { __builtin_amdgcn_s_setprio(1); _Pragma("unroll") for (int m = 0; m < 4; ++m) _Pragma("unroll") for (int n = 0; n < 2; ++n) _Pragma("unroll") for (int k = 0; k < 2; ++k) \
        acc[ai][bj][m][n] = __builtin_amdgcn_mfma_f32_16x16x32_bf16(Bt[n][k], At[m][k], acc[ai][bj][m][n], 0, 0, 0); __builtin_amdgcn_s_setprio(0); } while (0)
#define PG8_WAIT_V(n) asm volatile("s_waitcnt vmcnt(" #n ")" ::: "memory")
#define PG8_WAIT_L(n) asm volatile("s_waitcnt lgkmcnt(" #n ")" ::: "memory")
#define PG8_BAR __builtin_amdgcn_s_barrier()
#define PG8_SCHED __builtin_amdgcn_sched_barrier(0)
    Unit cur, nxt; int ui = 0;
    if (!S.next(0, cur)) return;
    f32x4 acc[2][2][4][2];
#pragma unroll
    for (int a = 0; a < 2; ++a)
#pragma unroll
        for (int b = 0; b < 2; ++b)
#pragma unroll
            for (int m = 0; m < 4; ++m)
#pragma unroll
                for (int n = 0; n < 2; ++n) acc[a][b][m][n] = (f32x4){0.f, 0.f, 0.f, 0.f};
    bf16x8 At[4][2], B0[2][2], B1[2][2];
    const char* cA = (const char*)g.A + S.a_byte(cur, tstepA); const char* cB = (const char*)g.Bt + S.b_byte(cur, tstepB);
    PG8_STAGE(PG8_SB(0, 0), cB, voffB); PG8_STAGE(PG8_SB(0, 1), cB + hstepB, voffB); PG8_STAGE(PG8_SA(0, 0), cA, voffA); PG8_STAGE(PG8_SA(0, 1), cA + hstepA, voffA);
    if (wr == 1) PG8_BAR;
    PG8_WAIT_V(2); PG8_BAR;
    PG8_STAGE(PG8_SB(1, 0), cB + kstep, voffB); PG8_STAGE(PG8_SA(1, 0), cA + kstep, voffA); PG8_STAGE(PG8_SB(1, 1), cB + hstepB + kstep, voffB);
    PG8_WAIT_V(6); PG8_BAR;
    for (;;) {
        const bool has_next = S.next(ui + 1, nxt);
        const char* nA = has_next ? (const char*)g.A + S.a_byte(nxt, tstepA) : cA; const char* nB = has_next ? (const char*)g.Bt + S.b_byte(nxt, tstepB) : cB;
        for (int t = 0; t < nt; t += 2) {
            const bool last = (t == nt - 2);
            const char* a1 = cA + (size_t)(t + 1) * kstep;
            const char* a2 = last ? nA : cA + (size_t)(t + 2) * kstep; const char* b2 = last ? nB : cB + (size_t)(t + 2) * kstep;
            const char* a3 = a2 + kstep; const char* b3 = b2 + kstep;
            PG8_LDB(B0, 0, 0); PG8_LDB(B1, 0, 1); PG8_SCHED; PG8_LDA(At, 0, 0); PG8_STAGE(PG8_SA(1, 1), a1 + hstepA, voffA);
            PG8_WAIT_V(8); PG8_WAIT_L(0); PG8_BAR; PG8_MMA(0, 0, At, B0); PG8_MMA(0, 1, At, B1); PG8_BAR; PG8_SCHED;
            PG8_LDA(At, 0, 1); PG8_STAGE(PG8_SB(0, 0), b2, voffB); PG8_STAGE(PG8_SB(0, 1), b2 + hstepB, voffB); PG8_STAGE(PG8_SA(0, 0), a2, voffA);
            PG8_WAIT_V(8); PG8_WAIT_L(0); PG8_BAR; PG8_MMA(1, 0, At, B0); PG8_MMA(1, 1, At, B1); PG8_BAR; PG8_SCHED;
            PG8_LDB(B0, 1, 0); PG8_LDB(B1, 1, 1); PG8_SCHED; PG8_LDA(At, 1, 0); PG8_STAGE(PG8_SA(0, 1), a2 + hstepA, voffA);
            PG8_WAIT_V(8); PG8_WAIT_L(0); PG8_BAR; PG8_MMA(0, 0, At, B0); PG8_MMA(0, 1, At, B1); PG8_BAR; PG8_SCHED;
            PG8_LDA(At, 1, 1); PG8_STAGE(PG8_SB(1, 0), b3, voffB); PG8_STAGE(PG8_SB(1, 1), b3 + hstepB, voffB); PG8_STAGE(PG8_SA(1, 0), a3, voffA);
            PG8_WAIT_V(8); PG8_WAIT_L(0); PG8_BAR; PG8_MMA(1, 0, At, B0); PG8_MMA(1, 1, At, B1); PG8_BAR; PG8_SCHED;
        }
        if constexpr (ALIGN_EPI) { if (wr == 0) PG8_BAR; }
        E(acc, cur, wr, wc, fr, fq);
        if (!has_next) break;
#pragma unroll
        for (int a = 0; a < 2; ++a)
#pragma unroll
            for (int b = 0; b < 2; ++b)
#pragma unroll
                for (int m = 0; m < 4; ++m)
#pragma unroll
                    for (int n = 0; n < 2; ++n) acc[a][b][m][n] = (f32x4){0.f, 0.f, 0.f, 0.f};
        cur = nxt; cA = nA; cB = nB; ++ui;
        if constexpr (ALIGN_EPI) { if (wr == 1) PG8_BAR; }
    }
    PG8_WAIT_V(0);
    if constexpr (!ALIGN_EPI) { if (wr == 0) PG8_BAR; }
    PG8_BAR;
#undef PG8_SA
#undef PG8_SB
#undef PG8_STAGE
#undef PG8_LDA
#undef PG8_LDB
#undef PG8_MMA
#undef PG8_WAIT_V
#undef PG8_WAIT_L
#undef PG8_BAR
#undef PG8_SCHED
}
}

#define XB_TMO      128
#define XB_XCNT(j)  (256  + 64 * (j))
#define XB_XSUB(j)  (1280 + 64 * (j))
#define XB_XGEN(j)  (2304 + 64 * (j))
#define XB_TOP      3328
#define XB_TOPGEN   3392
#define XCD_BAR_WORDS 3456
#define XB_SPIN_CAP (1u << 20)

__device__ __forceinline__ unsigned xb_ld(unsigned* p)              { return __hip_atomic_load(p, __ATOMIC_RELAXED, __HIP_MEMORY_SCOPE_AGENT); }
__device__ __forceinline__ unsigned xb_add(unsigned* p, unsigned v) { return __hip_atomic_fetch_add(p, v, __ATOMIC_RELAXED, __HIP_MEMORY_SCOPE_AGENT); }
__device__ __forceinline__ unsigned xb_xcc_id() { return (unsigned)__builtin_amdgcn_s_getreg((3 << 11) | 20) & 0xFu; }
#define XB_SPIN(cond, bar) do { unsigned _sp = 0; while (cond) { __builtin_amdgcn_s_sleep(1); \
    if ((++_sp & 255u) == 0u) { if (xb_ld(&(bar)[XB_TMO])) break; if (_sp > XB_SPIN_CAP) { atomicAdd(&(bar)[XB_TMO], 1u); break; } } } } while (0)

struct XcdBarrier {
    unsigned* bar; unsigned x;
    volatile LAS unsigned* st;
};
__device__ __forceinline__ XcdBarrier xcd_barrier_post(unsigned* bar, volatile LAS unsigned* st) {
    XcdBarrier b; b.bar = bar; b.x = xb_xcc_id(); b.st = st;
    if (threadIdx.x == 0) (void)xb_add(&bar[XB_XCNT(b.x)], 1u);
    return b;
}
__device__ __forceinline__ void xcd_barrier_complete(unsigned* bar, unsigned x, unsigned& nloc, unsigned& nx) {
    const unsigned G = gridDim.x * gridDim.y * gridDim.z;
    unsigned sum, cnt, mine, sp = 0u;
    for (;;) {
        sum = 0u; cnt = 0u; mine = 0u;
#pragma unroll
        for (unsigned j = 0; j < 16; ++j) { const unsigned c = xb_ld(&bar[XB_XCNT(j)]); sum += c; cnt += (c > 0u) ? 1u : 0u; mine = (j == x) ? c : mine; }
        if (sum == G) break;
        __builtin_amdgcn_s_sleep(1);
        if ((++sp & 255u) == 0u) { if (xb_ld(&bar[XB_TMO])) break; if (sp > XB_SPIN_CAP) { atomicAdd(&bar[XB_TMO], 1u); break; } }
    }
    nloc = mine > 0u ? mine : 1u; nx = cnt > 0u ? cnt : 1u;
}
__device__ __forceinline__ void xcd_barrier(const XcdBarrier& b) {
    asm volatile("s_waitcnt vmcnt(0)" ::: "memory");
    __syncthreads();
    if (threadIdx.x == 0) {
        unsigned* bar = b.bar;
        __builtin_amdgcn_s_waitcnt(0);
        unsigned nloc = b.st[0], nx = b.st[1];
        if (nloc == 0u) { xcd_barrier_complete(bar, b.x, nloc, nx); b.st[0] = nloc; b.st[1] = nx; }
        const unsigned old = xb_add(&bar[XB_XSUB(b.x)], 1u);
        const unsigned gen = old / nloc;
        if (old + 1u == (gen + 1u) * nloc) {
            __builtin_amdgcn_fence(__ATOMIC_RELEASE, "agent");
            asm volatile("s_waitcnt vmcnt(0)" ::: "memory");
            const unsigned og = xb_add(&bar[XB_TOP], 1u);
            const unsigned tg = og / nx;
            if (og + 1u == (tg + 1u) * nx) xb_add(&bar[XB_TOPGEN], 1u);
            else XB_SPIN(xb_ld(&bar[XB_TOPGEN]) == tg, bar);
            __builtin_amdgcn_fence(__ATOMIC_ACQUIRE, "agent");
            xb_add(&bar[XB_XGEN(b.x)], 1u);
            asm volatile("s_waitcnt vmcnt(0)" ::: "memory");
        } else {
            XB_SPIN(xb_ld(&bar[XB_XGEN(b.x)]) == gen, bar);
            __builtin_amdgcn_fence(__ATOMIC_ACQUIRE, "agent");
            asm volatile("s_waitcnt vmcnt(0)" ::: "memory");
        }
    }
    __syncthreads();
}

namespace att16 {
constexpr int DQK = 192, DV = 128, NW = 8, KVBLK = 64;
constexpr float SCALE = 0.07216878364870322f, QSCALE = SCALE * 1.4426950408889634f  , THR2 = 8.f * 1.4426950408889634f  ;
constexpr int LDQ = 3072, LDKV = 4096, LDKR = 64, LDO = 2048;
constexpr int VSTR = 2080;
constexpr int SHM_V = 8 * VSTR, SHM_K = KVBLK * DQK * 2, SHM_WS = 2 * SHM_V + 2 * SHM_K, SHM_ATTN = SHM_WS + NW * 64 * 4;
using s16x4 = __attribute__((ext_vector_type(4))) short;
#define KSWZ(row, colB) ((row) * 384 + ((colB) ^ ((((row) >> 1) & 7) << 4)))
#define SBAR() __builtin_amdgcn_sched_barrier(0)
__device__ __forceinline__ unsigned cvtpk(float lo, float hi) { unsigned r; asm volatile("v_cvt_pk_bf16_f32 %0, %1, %2" : "=v"(r) : "v"(lo), "v"(hi)); return r; }
template <int OFF> __device__ __forceinline__ s16x4 tr_read(int vb) { s16x4 r; asm volatile("ds_read_b64_tr_b16 %0, %1 offset:%2" : "=&v"(r) : "v"(vb), "i"(OFF) : "memory"); return r; }
__device__ __forceinline__ float red4(float x, bool is_max) {
  { auto r16 = __builtin_amdgcn_permlane16_swap(__float_as_uint(x), __float_as_uint(x), false, false);
    const float a = __uint_as_float(r16[0]), b = __uint_as_float(r16[1]); x = is_max ? fmaxf(a, b) : a + b; }
  auto rr = __builtin_amdgcn_permlane32_swap(__float_as_uint(x), __float_as_uint(x), false, false);
  const float a = __uint_as_float(rr[0]), b = __uint_as_float(rr[1]);
  return is_max ? fmaxf(a, b) : a + b;
}
struct VF { s16x4 a0, a1, b0, b1; };
template <int DB> __device__ __forceinline__ void v_rd(VF& f, int vb) { f.a0 = tr_read<DB * VSTR + 0>(vb); f.a1 = tr_read<DB * VSTR + 512>(vb); f.b0 = tr_read<DB * VSTR + 1024>(vb); f.b1 = tr_read<DB * VSTR + 1536>(vb); }
template <int DB> __device__ __forceinline__ void v_mm(f32x4 (&o)[2][8], const VF& f, const bf16x8 (&pa)[2][2]) {
  const bf16x8 v0 = (bf16x8){f.a0[0], f.a0[1], f.a0[2], f.a0[3], f.a1[0], f.a1[1], f.a1[2], f.a1[3]}, v1 = (bf16x8){f.b0[0], f.b0[1], f.b0[2], f.b0[3], f.b1[0], f.b1[1], f.b1[2], f.b1[3]};
  o[0][DB] = __builtin_amdgcn_mfma_f32_16x16x32_bf16(pa[0][0], v0, o[0][DB], 0, 0, 0);
  o[1][DB] = __builtin_amdgcn_mfma_f32_16x16x32_bf16(pa[1][0], v0, o[1][DB], 0, 0, 0);
  o[0][DB] = __builtin_amdgcn_mfma_f32_16x16x32_bf16(pa[0][1], v1, o[0][DB], 0, 0, 0);
  o[1][DB] = __builtin_amdgcn_mfma_f32_16x16x32_bf16(pa[1][1], v1, o[1][DB], 0, 0, 0);
}
__device__ __forceinline__ void pv_all(f32x4 (&o)[2][8], f32x4 (&ls)[2], int vb, const bf16x8 (&pa)[2][2]) {
  VF f0, f1, f2;
  asm volatile("s_waitcnt lgkmcnt(0)" ::: "memory");
  v_rd<0>(f0, vb); v_rd<1>(f1, vb);
#define W(N) asm volatile("s_waitcnt lgkmcnt(" #N ")" ::: "memory"); SBAR()
  v_rd<2>(f2, vb); W(8); v_mm<0>(o, f0, pa); SBAR();
  v_rd<3>(f0, vb); W(8); v_mm<1>(o, f1, pa); SBAR();
  v_rd<4>(f1, vb); W(8); v_mm<2>(o, f2, pa); SBAR();
  v_rd<5>(f2, vb); W(8); v_mm<3>(o, f0, pa); SBAR();
  v_rd<6>(f0, vb); W(8); v_mm<4>(o, f1, pa); SBAR();
  v_rd<7>(f1, vb); W(8); v_mm<5>(o, f2, pa); SBAR();
  W(4); v_mm<6>(o, f0, pa); SBAR();
  W(0); v_mm<7>(o, f1, pa);
#undef W
  const bf16x8 ones = {(short)0x3F80, (short)0x3F80, (short)0x3F80, (short)0x3F80, (short)0x3F80, (short)0x3F80, (short)0x3F80, (short)0x3F80};
  ls[0] = __builtin_amdgcn_mfma_f32_16x16x32_bf16(pa[0][0], ones, ls[0], 0, 0, 0); ls[1] = __builtin_amdgcn_mfma_f32_16x16x32_bf16(pa[1][0], ones, ls[1], 0, 0, 0);
  ls[0] = __builtin_amdgcn_mfma_f32_16x16x32_bf16(pa[0][1], ones, ls[0], 0, 0, 0); ls[1] = __builtin_amdgcn_mfma_f32_16x16x32_bf16(pa[1][1], ones, ls[1], 0, 0, 0);
}
__device__ __forceinline__ void attn_body(const bf16_t* __restrict__ Qb, const bf16_t* __restrict__ Kh, const bf16_t* __restrict__ Vh, const bf16_t* __restrict__ KRh,
                                          bf16_t* __restrict__ Ob, int seq, char* lds) {
  const int tid = threadIdx.x, wid = tid >> 6, lane = tid & 63, c15 = lane & 15, g = lane >> 4;
  char* V_lds = lds; char* K_lds = lds + 2 * SHM_V;
  float* ws = (float*)(lds + SHM_WS) + wid * 64; float* al_l = ws + 32;
  float m_reg[2] = {0.f, 0.f};
  f32x4 ls[2] = {(f32x4){0.f, 0.f, 0.f, 0.f}, (f32x4){0.f, 0.f, 0.f, 0.f}};
  f32x4 o[2][8];
#pragma unroll
  for (int qb = 0; qb < 2; ++qb)
#pragma unroll
    for (int db = 0; db < 8; ++db) o[qb][db] = (f32x4){0.f, 0.f, 0.f, 0.f};
  bf16x8 qf[2][6];
#pragma unroll
  for (int qb = 0; qb < 2; ++qb)
#pragma unroll
    for (int ks = 0; ks < 6; ++ks) qf[qb][ks] = *reinterpret_cast<const bf16x8*>(Qb + (long)(wid * 32 + 16 * qb + c15) * LDQ + 32 * ks + 8 * g);
  const int sr = tid >> 4, sc = (tid & 15) * 8, rr = tid >> 3, rc = (tid & 7) * 8;
  const int vst0 = (sc >> 4) * VSTR + (sr >> 2) * 128 + (sr & 3) * 32 + ((sc >> 3) & 1) * 16;
  const int ksw0 = KSWZ(sr, sc * 2), ksw2 = KSWZ(rr, 256 + rc * 2);
  int kbase[2];
#pragma unroll
  for (int e = 0; e < 2; ++e) kbase[e] = c15 * 384 + ((64 * e + 16 * g) ^ (((c15 >> 1) & 7) << 4));
  const int vb0 = (int)(uintptr_t)V_lds + g * 128 + c15 * 8;
  bf16x8 vs0, vs1, ks0, ks1, kr0;
  const unsigned kvoff = (unsigned)((sr * LDKV + sc) * 2), kvoff2 = kvoff + 32u * LDKV * 2u, kroff = (unsigned)((rr * LDKR + rc) * 2);
  const __amdgpu_buffer_rsrc_t rkv = __builtin_amdgcn_make_buffer_rsrc((void*)Kh, 0, 0x7fffffff, 0x00020000), rkr = __builtin_amdgcn_make_buffer_rsrc((void*)KRh, 0, 0x7fffffff, 0x00020000);
  (void)Vh;
#define BLD(R, VO, SO) __builtin_bit_cast(bf16x8, __builtin_amdgcn_raw_buffer_load_b128((R), (VO), (SO), 0))
#define SLOAD(k0) do { const unsigned so_ = (unsigned)(k0) * (unsigned)(LDKV * 2), sr_ = (unsigned)(k0) * (unsigned)(LDKR * 2); \
    vs0 = BLD(rkv, kvoff + 256u, so_); vs1 = BLD(rkv, kvoff2 + 256u, so_); ks0 = BLD(rkv, kvoff, so_); ks1 = BLD(rkv, kvoff2, so_); kr0 = BLD(rkr, kroff, sr_); } while (0)
#define SWRITE(b) do { *(bf16x8*)(V_lds + (b) * SHM_V + vst0) = vs0; *(bf16x8*)(V_lds + (b) * SHM_V + vst0 + 1024) = vs1; \
    *(bf16x8*)(K_lds + (b) * SHM_K + ksw0) = ks0; *(bf16x8*)(K_lds + (b) * SHM_K + ksw0 + 32 * 384) = ks1; *(bf16x8*)(K_lds + (b) * SHM_K + ksw2) = kr0; } while (0)
  const int NT = seq / KVBLK;
  SLOAD(0); asm volatile("s_waitcnt vmcnt(0)" ::: "memory"); SWRITE(0); __syncthreads();
#define KADDR(F, B) (K_lds + (B) * SHM_K + kbase[((F) % 6) & 1] + ((F) / 6) * (16 * 384) + (((F) % 6) >> 1) * 128)
#define KRD(FR, G, B) do { _Pragma("unroll") for (int i_ = 0; i_ < 4; ++i_) FR[i_] = *reinterpret_cast<const bf16x8*>(KADDR(4 * (G) + i_, B)); } while (0)
#define KMM(FR, G) do { _Pragma("unroll") for (int i_ = 0; i_ < 4; ++i_) { const int f_ = 4 * (G) + i_, kb_ = f_ / 6, ks_ = f_ % 6; \
        st[0][kb_] = __builtin_amdgcn_mfma_f32_16x16x32_bf16(FR[i_], qf[0][ks_], (ks_ == 0) ? ng4[0] : st[0][kb_], 0, 0, 0);   \
        st[1][kb_] = __builtin_amdgcn_mfma_f32_16x16x32_bf16(FR[i_], qf[1][ks_], (ks_ == 0) ? ng4[1] : st[1][kb_], 0, 0, 0); } } while (0)
#define TILE(B, NEXTK, HASNEXT, FIRST) do { \
    f32x4 st[2][4], ng4[2];   \
    _Pragma("unroll") for (int qb = 0; qb < 2; ++qb) { float ng = -m_reg[qb]; asm volatile("" : "+v"(ng)); ng4[qb] = (f32x4){ng, ng, ng, ng}; } \
    SBAR(); __builtin_amdgcn_s_setprio(1); \
    { bf16x8 fa[4], fb[4];   \
      KRD(fa, 0, B); SBAR(); \
      KRD(fb, 1, B); SBAR(); KMM(fa, 0); SBAR(); \
      KRD(fa, 2, B); SBAR(); KMM(fb, 1); SBAR(); \
      KRD(fb, 3, B); SBAR(); KMM(fa, 2); SBAR(); \
      KRD(fa, 4, B); SBAR(); KMM(fb, 3); SBAR(); \
      KRD(fb, 5, B); SBAR(); KMM(fa, 4); SBAR(); \
      KMM(fb, 5); } \
    __builtin_amdgcn_s_setprio(0); SBAR(); \
    if (HASNEXT) SLOAD(NEXTK); SBAR(); \
    { float pm[2]; \
      _Pragma("unroll") for (int qb = 0; qb < 2; ++qb) { float x = st[qb][0][0]; \
          _Pragma("unroll") for (int kb = 0; kb < 4; ++kb) _Pragma("unroll") for (int r = 0; r < 4; ++r) x = fmaxf(x, st[qb][kb][r]); \
          pm[qb] = red4(x, true); } \
      if ((FIRST) || !__builtin_expect(__all((pm[0] <= THR2) && (pm[1] <= THR2)), 1)) { \
          float al[2]; \
          _Pragma("unroll") for (int qb = 0; qb < 2; ++qb) { const float dl = (FIRST) ? pm[qb] : fmaxf(pm[qb], 0.f); m_reg[qb] += dl; al[qb] = __builtin_amdgcn_exp2f(-dl); \
              _Pragma("unroll") for (int kb = 0; kb < 4; ++kb) st[qb][kb] -= dl; } \
          if (!(FIRST)) { if (g == 0) { al_l[c15] = al[0]; al_l[16 + c15] = al[1]; } asm volatile("s_waitcnt lgkmcnt(0)" ::: "memory"); \
              _Pragma("unroll") for (int qb = 0; qb < 2; ++qb) { const f32x4 a4 = *(const f32x4*)(al_l + 16 * qb + 4 * g); ls[qb] *= a4; \
                  _Pragma("unroll") for (int db = 0; db < 8; ++db) o[qb][db] *= a4; } } } } \
    bf16x8 pa[2][2]; \
    _Pragma("unroll") for (int qb = 0; qb < 2; ++qb) { \
        _Pragma("unroll") for (int kb = 0; kb < 4; ++kb) _Pragma("unroll") for (int r = 0; r < 4; ++r) st[qb][kb][r] = __builtin_amdgcn_exp2f(st[qb][kb][r]); \
        _Pragma("unroll") for (int s2 = 0; s2 < 2; ++s2) { u32x4 w = {cvtpk(st[qb][2 * s2][0], st[qb][2 * s2][1]), cvtpk(st[qb][2 * s2][2], st[qb][2 * s2][3]), \
                                                                  cvtpk(st[qb][2 * s2 + 1][0], st[qb][2 * s2 + 1][1]), cvtpk(st[qb][2 * s2 + 1][2], st[qb][2 * s2 + 1][3])}; \
            pa[qb][s2] = *reinterpret_cast<bf16x8*>(&w); } } \
    SBAR(); __builtin_amdgcn_s_setprio(1); \
    { const int vb = vb0 + (B) * SHM_V; \
      pv_all(o, ls, vb, pa); } \
    __builtin_amdgcn_s_setprio(0); \
    if (HASNEXT) { asm volatile("s_waitcnt vmcnt(0)" ::: "memory"); SWRITE(1 - (B)); } \
    __syncthreads(); } while (0)
  TILE(0, KVBLK, true, true); TILE(1, 2 * KVBLK, true, false);
  for (int j = 2; j + 2 < NT; j += 2) { TILE(0, (j + 1) * KVBLK, true, false); TILE(1, (j + 2) * KVBLK, true, false); }
  TILE(0, (NT - 1) * KVBLK, true, false); TILE(1, 0, false, false);
#undef TILE
#undef KADDR
#undef KRD
#undef KMM
#undef SLOAD
#undef BLD
#undef SWRITE
#pragma unroll
  for (int qb = 0; qb < 2; ++qb) {
#pragma unroll
    for (int r = 0; r < 4; ++r) { const float rl = __builtin_amdgcn_rcpf(ls[qb][r]); bf16_t* orow = Ob + (long)(wid * 32 + 16 * qb + 4 * g + r) * LDO + c15;
#pragma unroll
      for (int db = 0; db < 8; ++db) orow[16 * db] = f2bf(o[qb][db][r] * rl); } }
}
#undef KSWZ
#undef SBAR
}

namespace fft {
constexpr int N = 16384, ROWP = 528, LDS_FFT_BYTES = 32 * ROWP * 8;
__device__ constexpr float C32[16] = {1.000000000e+00f, 9.807852804e-01f, 9.238795325e-01f, 8.314696123e-01f, 7.071067812e-01f, 5.555702330e-01f, 3.826834324e-01f, 1.950903220e-01f, 0.0f, -1.950903220e-01f, -3.826834324e-01f, -5.555702330e-01f, -7.071067812e-01f, -8.314696123e-01f, -9.238795325e-01f, -9.807852804e-01f};
__device__ constexpr float S32[16] = {0.000000000e+00f, 1.950903220e-01f, 3.826834324e-01f, 5.555702330e-01f, 7.071067812e-01f, 8.314696123e-01f, 9.238795325e-01f, 9.807852804e-01f, 1.000000000e+00f, 9.807852804e-01f, 9.238795325e-01f, 8.314696123e-01f, 7.071067812e-01f, 5.555702330e-01f, 3.826834324e-01f, 1.950903220e-01f};
__device__ constexpr float C64[32] = {1.000000000e+00f, 9.951847267e-01f, 9.807852804e-01f, 9.569403357e-01f, 9.238795325e-01f, 8.819212643e-01f, 8.314696123e-01f, 7.730104534e-01f, 7.071067812e-01f, 6.343932842e-01f, 5.555702330e-01f, 4.713967368e-01f, 3.826834324e-01f, 2.902846773e-01f, 1.950903220e-01f, 9.801714033e-02f, 0.0f, -9.801714033e-02f, -1.950903220e-01f, -2.902846773e-01f, -3.826834324e-01f, -4.713967368e-01f, -5.555702330e-01f, -6.343932842e-01f, -7.071067812e-01f, -7.730104534e-01f, -8.314696123e-01f, -8.819212643e-01f, -9.238795325e-01f, -9.569403357e-01f, -9.807852804e-01f, -9.951847267e-01f};
__device__ constexpr float S64[32] = {0.000000000e+00f, 9.801714033e-02f, 1.950903220e-01f, 2.902846773e-01f, 3.826834324e-01f, 4.713967368e-01f, 5.555702330e-01f, 6.343932842e-01f, 7.071067812e-01f, 7.730104534e-01f, 8.314696123e-01f, 8.819212643e-01f, 9.238795325e-01f, 9.569403357e-01f, 9.807852804e-01f, 9.951847267e-01f, 1.000000000e+00f, 9.951847267e-01f, 9.807852804e-01f, 9.569403357e-01f, 9.238795325e-01f, 8.819212643e-01f, 8.314696123e-01f, 7.730104534e-01f, 7.071067812e-01f, 6.343932842e-01f, 5.555702330e-01f, 4.713967368e-01f, 3.826834324e-01f, 2.902846773e-01f, 1.950903220e-01f, 9.801714033e-02f};
__host__ __device__ constexpr int brev(int k, int bits) { int r = 0; for (int i = 0; i < bits; ++i) r = (r << 1) | ((k >> i) & 1); return r; }

typedef f32x2 cf;
__device__ __forceinline__ cf cmul(cf a, cf w) { cf t, r;
    asm("v_pk_mul_f32 %0, %1, %2 op_sel_hi:[1,0]" : "=v"(t) : "v"(a), "v"(w));
    asm("v_pk_fma_f32 %0, %1, %2, %3 op_sel:[1,1,0] op_sel_hi:[0,1,1] neg_lo:[1,0,0]" : "=v"(r) : "v"(a), "v"(w), "v"(t));
    return r; }
__device__ __forceinline__ cf cmul_k(cf a, float c, float s) { const cf w = {c, s}; cf t, r;
    asm("v_pk_mul_f32 %0, %1, %2 op_sel_hi:[1,0]" : "=v"(t) : "v"(a), "s"(w));
    asm("v_pk_fma_f32 %0, %1, %2, %3 op_sel:[1,1,0] op_sel_hi:[0,1,1] neg_lo:[1,0,0]" : "=v"(r) : "v"(a), "s"(w), "v"(t));
    return r; }
template <bool INV> __device__ __forceinline__ cf sub_rot(cf a, cf c) { cf r;
    if constexpr (!INV) asm("v_pk_add_f32 %0, %1, %2 op_sel:[1,1] op_sel_hi:[0,0] neg_lo:[0,1] neg_hi:[1,0]" : "=v"(r) : "v"(a), "v"(c));
    else asm("v_pk_add_f32 %0, %1, %2 op_sel:[1,1] op_sel_hi:[0,0] neg_lo:[1,0] neg_hi:[0,1]" : "=v"(r) : "v"(a), "v"(c));
    return r; }
__device__ __forceinline__ cf cadd(cf a, cf c) { return a + c; }
__device__ __forceinline__ cf csub(cf a, cf c) { return a - c; }
template <int R, int LEN, bool INV, int OFF>
__device__ __forceinline__ void stage(cf (&x)[32]) {
    constexpr int half = LEN / 2, tws = 32 / LEN;
#pragma unroll
    for (int b = 0; b < R; b += LEN)
#pragma unroll
        for (int j = 0; j < half; ++j) {
            const int i0 = OFF + b + j, i1 = i0 + half;
            const cf a = x[i0], c = x[i1];
            x[i0] = cadd(a, c);
            const int e = j * tws;
            if (e == 0) x[i1] = csub(a, c);
            else if (e == 8) x[i1] = sub_rot<INV>(a, c);
            else x[i1] = cmul_k(csub(a, c), C32[e], INV ? S32[e] : -S32[e]);
        }
}
template <int R, bool INV, int OFF>
__device__ __forceinline__ void dft(cf (&x)[32]) {
    if constexpr (R >= 32) stage<R, 32, INV, OFF>(x);
    if constexpr (R >= 16) stage<R, 16, INV, OFF>(x);
    stage<R, 8, INV, OFF>(x); stage<R, 4, INV, OFF>(x); stage<R, 2, INV, OFF>(x);
}
struct Tw {
    float wAr, wAi;
    float wBr, wBi;
    float wCr, wCi;
    float wD0r, wD0i;
    float wDr, wDi;
    float wMr, wMi;
};
__device__ __forceinline__ void tw_init(Tw& t, int tid) {
    float s, c;
    sincospif(-2.0f * (float)tid / 16384.0f, &s, &c); t.wAr = c; t.wAi = s;
    sincospif(-2.0f * (float)(tid & 15) / 512.0f, &s, &c); t.wBr = c; t.wBi = s;
    sincospif(2.0f * (float)(tid & 31) / 512.0f, &s, &c); t.wCr = c; t.wCi = s;
    sincospif(2.0f * (float)((tid >> 4) * (tid & 15)) / 16384.0f, &s, &c); t.wD0r = c; t.wD0i = s;
    sincospif(2.0f * (float)(tid >> 4) / 1024.0f, &s, &c); t.wDr = c; t.wDi = s;
    sincospif(-(float)tid / 16384.0f, &s, &c); t.wMr = c; t.wMi = s;
}
#define FFT_SYNC() do { asm volatile("s_waitcnt lgkmcnt(0)" ::: "memory"); __builtin_amdgcn_s_barrier(); asm volatile("" ::: "memory"); } while (0)
__device__ __forceinline__ int opq(int x) { asm volatile("" : "+v"(x)); return x; }
__device__ __forceinline__ float opqf(float x) { asm volatile("" : "+v"(x)); return x; }
__device__ __forceinline__ void fwd(cf (&x)[32], LAS f32x2* X, const Tw& t, int tid_) {
    dft<32, false, 0>(x);
    { const int tid = opq(tid_); const cf w = {opqf(t.wAr), opqf(t.wAi)}; cf p = {1.f, 0.f}; const int rb = (tid & ~15), rs = tid & 15, key = (tid >> 5) & 15; const int col = rb + (rs ^ key);
#pragma unroll
      for (int k1 = 0; k1 < 32; ++k1) { X[k1 * ROWP + col] = cmul(x[brev(k1, 5)], p); p = cmul(p, w); } }
    FFT_SYNC();
    { const int tid = opq(tid_); const cf w = {opqf(t.wBr), opqf(t.wBi)}; const int k1 = tid >> 4, s = tid & 15; LAS f32x2* row = X + k1 * ROWP;
#pragma unroll
      for (int r1 = 0; r1 < 32; ++r1) x[r1] = row[r1 * 16 + (s ^ ((r1 >> 1) & 15))];
      dft<32, false, 0>(x);
      cf p = {1.f, 0.f};
#pragma unroll
      for (int k2 = 0; k2 < 32; ++k2) { row[k2 * 16 + (s ^ ((k2 >> 1) & 15))] = cmul(x[brev(k2, 5)], p); p = cmul(p, w); } }
    FFT_SYNC();
    { const int tid = opq(tid_); const int k2 = tid & 31, key = (k2 >> 1) & 15;
#pragma unroll
      for (int j = 0; j < 2; ++j) { const int k1 = (tid + 512 * j) >> 5; LAS f32x2* p = X + k1 * ROWP + k2 * 16;
#pragma unroll
          for (int s = 0; s < 16; ++s) x[16 * j + s] = p[s ^ key]; }
      dft<16, false, 0>(x); dft<16, false, 16>(x); }
    FFT_SYNC();
}
__device__ __forceinline__ void inv(cf (&x)[32], LAS f32x2* X, const Tw& t, int tid_) {
    { const int tid = opq(tid_); const cf w = {opqf(t.wCr), opqf(t.wCi)}; cf y[32];
#pragma unroll
      for (int j = 0; j < 2; ++j)
#pragma unroll
          for (int k3 = 0; k3 < 16; ++k3) y[16 * j + k3] = x[16 * j + brev(k3, 4)];
      dft<16, true, 0>(y); dft<16, true, 16>(y);
      const int k2 = tid & 31, key = (k2 >> 1) & 15;
#pragma unroll
      for (int j = 0; j < 2; ++j) { const int k1 = (tid + 512 * j) >> 5; LAS f32x2* p = X + k1 * ROWP + k2 * 16; cf q = {1.f, 0.f};
#pragma unroll
          for (int s = 0; s < 16; ++s) { p[s ^ key] = cmul(y[16 * j + brev(s, 4)], q); q = cmul(q, w); } } }
    FFT_SYNC();
    { const int tid = opq(tid_); const cf w = {opqf(t.wDr), opqf(t.wDi)}; const int k1 = tid >> 4, s = tid & 15; LAS f32x2* row = X + k1 * ROWP;
#pragma unroll
      for (int k2 = 0; k2 < 32; ++k2) x[k2] = row[k2 * 16 + (s ^ ((k2 >> 1) & 15))];
      dft<32, true, 0>(x);
      cf p = {opqf(t.wD0r), opqf(t.wD0i)};
#pragma unroll
      for (int r1 = 0; r1 < 32; ++r1) { row[r1 * 16 + (s ^ ((r1 >> 1) & 15))] = cmul(x[brev(r1, 5)], p); p = cmul(p, w); } }
    FFT_SYNC();
    { const int tid = opq(tid_); const int rb = (tid & ~15), rs = tid & 15, key = (tid >> 5) & 15; const int col = rb + (rs ^ key);
      cf y[32];
#pragma unroll
      for (int k1 = 0; k1 < 32; ++k1) y[k1] = X[k1 * ROWP + col];
      dft<32, true, 0>(y);
#pragma unroll
      for (int n1 = 0; n1 < 32; ++n1) x[n1] = y[brev(n1, 5)]; }
    FFT_SYNC();
}

__device__ __forceinline__ float conv3(const bf16_t* seg, int n, int len, float b, float w0, float w1, float w2, float cb) {
    const float pm = (n > 0) ? bf2f(seg[n - 1]) + b : 0.f, pc = bf2f(seg[n]) + b, pp = (n + 1 < len) ? bf2f(seg[n + 1]) + b : 0.f;
    return w0 * pm + w1 * pc + w2 * pp + cb;
}
__device__ __forceinline__ float conv3l(const LAS bf16_t* seg, int n, float b, float w0, float w1, float w2, float cb) {
    const float pm = (n > 0) ? bf2f(seg[n - 1]) + b : 0.f, pc = bf2f(seg[n]) + b, pp = (n + 1 < 16384) ? bf2f(seg[n + 1]) + b : 0.f;
    return w0 * pm + w1 * pc + w2 * pp + cb;
}
struct ConvCh {
    float b0, b1, bv, w00, w01, w02, c0, w10, w11, w12, c1, wv0, wv1, wv2, cv;
};
__device__ __forceinline__ void load_ch(ConvCh& p, const float* b_in, const float* conv_w, const float* conv_b, int d) {
    p.b0 = b_in[d]; p.b1 = b_in[D + d]; p.bv = b_in[2 * D + d];
    p.w00 = conv_w[d]; p.w01 = conv_w[3 * D + d]; p.w02 = conv_w[6 * D + d]; p.c0 = conv_b[d];
    p.w10 = conv_w[D + d]; p.w11 = conv_w[3 * D + D + d]; p.w12 = conv_w[6 * D + D + d]; p.c1 = conv_b[D + d];
    p.wv0 = conv_w[2 * D + d]; p.wv1 = conv_w[3 * D + 2 * D + d]; p.wv2 = conv_w[6 * D + 2 * D + d]; p.cv = conv_b[2 * D + d];
}

__device__ __forceinline__ f32x2 unpk(unsigned w) { return (f32x2){__uint_as_float(w << 16), __uint_as_float(w & 0xffff0000u)}; }
__device__ __forceinline__ void conv_channel(int d, const bf16_t* projT, const float* filtT, const float* b_in, const float* conv_w, const float* conv_b, const float* hy_bias,
                                             bf16_t* yT, unsigned* scr, LAS unsigned char* lds, const Tw& tw, int tid, float (&hn)[32], int dnext) {
    LAS f32x2* X = (LAS f32x2*)lds; LAS float* red = (LAS float*)(lds + LDS_FFT_BYTES); const int tid_ = tid;
    unsigned* He = scr; unsigned* Ho = scr + 32 * 512;
    cf x[32]; unsigned pk[32];
    float scale; const float bias = hy_bias[d];
    { float s = 0.f; const int tq1 = opq(tid_);
#pragma unroll
      for (int n1 = 0; n1 < 32; ++n1) s += fabsf(hn[n1]);
      s = wave_sum(s); if ((tid & 63) == 0) red[tid >> 6] = s; __syncthreads();
      float tot = 0.f;
#pragma unroll
      for (int w = 0; w < 8; ++w) tot += red[w];
      scale = 1.0f / tot;
#pragma unroll
      for (int n1 = 0; n1 < 32; ++n1) { hn[n1] *= scale; if (n1 == 16 && tq1 == 0) hn[n1] += bias; x[n1] = (cf){hn[n1], 0.f}; } }
    fwd(x, X, tw, tid);
    { const int tq3 = opq(tid_);
#pragma unroll
    for (int i = 0; i < 32; ++i) He[i * 512 + tq3] = cvt_pk_bf16(x[i].x, x[i].y);
    }
#pragma unroll
    for (int n1 = 0; n1 < 32; ++n1) { const float wMr = opqf(tw.wMr), wMi = opqf(tw.wMi); const float mr = wMr * C64[n1] + wMi * S64[n1], mi = wMi * C64[n1] - wMr * S64[n1];
        x[n1] = (cf){hn[n1] * mr, hn[n1] * mi}; }
    const bf16_t* r0 = projT + (size_t)d * TM; const bf16_t* r1 = projT + (size_t)(D + d) * TM; const bf16_t* rv = projT + (size_t)(2 * D + d) * TM;
    u32x4 st[16];
    { const int tq6 = opq(tid_);
#pragma unroll
      for (int i = 0; i < 4; ++i) { const int c = (tq6 + 512 * i) * 8;
          st[i] = *(const u32x4*)(rv + c); st[4 + i] = *(const u32x4*)(r1 + c); st[8 + i] = *(const u32x4*)(rv + TB + c); st[12 + i] = *(const u32x4*)(r1 + TB + c); } }
    fwd(x, X, tw, tid);
    { const int tq5 = opq(tid_);
#pragma unroll
    for (int i = 0; i < 32; ++i) Ho[i * 512 + tq5] = cvt_pk_bf16(x[i].x, x[i].y);
    }
    { const int tq6 = opq(tid_);
#pragma unroll
      for (int q = 0; q < 4; ++q)
#pragma unroll
          for (int i = 0; i < 4; ++i) *(LAS u32x4*)(lds + q * 32768 + (tq6 + 512 * i) * 16) = st[4 * q + i]; }
    __syncthreads();
    { ConvCh p; load_ch(p, b_in, conv_w, conv_b, d); const int tq6 = opq(tid_);
      const LAS bf16_t* lv0 = (const LAS bf16_t*)lds; const LAS bf16_t* l10 = lv0 + 16384; const LAS bf16_t* lv1 = lv0 + 32768; const LAS bf16_t* l11 = lv0 + 49152;
#pragma unroll
      for (int n1 = 0; n1 < 32; ++n1) { const int n = 512 * n1 + tq6;
        x[n1].x = conv3l(lv0, n, p.bv, p.wv0, p.wv1, p.wv2, p.cv) * conv3l(l10, n, p.b1, p.w10, p.w11, p.w12, p.c1);
        x[n1].y = conv3l(lv1, n, p.bv, p.wv0, p.wv1, p.wv2, p.cv) * conv3l(l11, n, p.b1, p.w10, p.w11, p.w12, p.c1);
        pk[n1] = cvt_pk_bf16(x[n1].x, x[n1].y); } }
    __syncthreads();
    { unsigned hk[32]; { const int tq7 = opq(tid_);
#pragma unroll
      for (int i = 0; i < 32; ++i) hk[i] = He[i * 512 + tq7]; }
      fwd(x, X, tw, tid);
#pragma unroll
      for (int i = 0; i < 32; ++i) x[i] = cmul(x[i], unpk(hk[i])); }
    inv(x, X, tw, tid);
#pragma unroll
    for (int n1 = 0; n1 < 32; ++n1) { const float wMr = opqf(tw.wMr), wMi = opqf(tw.wMi); const float mr = wMr * C64[n1] + wMi * S64[n1], mi = wMi * C64[n1] - wMr * S64[n1];
        const unsigned z = pk[n1]; pk[n1] = cvt_pk_bf16(x[n1].x, x[n1].y); x[n1] = cmul(unpk(z), (cf){mr, mi}); }
    { unsigned hk[32]; { const int tq10 = opq(tid_);
#pragma unroll
      for (int i = 0; i < 32; ++i) hk[i] = Ho[i * 512 + tq10]; }
      fwd(x, X, tw, tid);
#pragma unroll
      for (int i = 0; i < 32; ++i) x[i] = cmul(x[i], unpk(hk[i])); }
    u32x4 st0[8];
    { const int tq12 = opq(tid_);
#pragma unroll
      for (int i = 0; i < 4; ++i) { const int c = (tq12 + 512 * i) * 8; st0[i] = *(const u32x4*)(r0 + c); st0[4 + i] = *(const u32x4*)(r0 + TB + c); } }
    inv(x, X, tw, tid);
    bf16_t* o0 = yT + (size_t)d * TM; bf16_t* o1 = o0 + TB;
    { const int tq12 = opq(tid_);
#pragma unroll
      for (int q = 0; q < 2; ++q)
#pragma unroll
          for (int i = 0; i < 4; ++i) *(LAS u32x4*)(lds + q * 32768 + (tq12 + 512 * i) * 16) = st0[4 * q + i]; }
    if (dnext < D) { const float* hnx = filtT + (size_t)dnext * N; const int tq13 = opq(tid_);
#pragma unroll
      for (int n1 = 0; n1 < 32; ++n1) hn[n1] = hnx[512 * n1 + tq13]; }
    __syncthreads();
    const float pb0 = b_in[d], pw0 = conv_w[d], pw1 = conv_w[3 * D + d], pw2 = conv_w[6 * D + d], pc0 = conv_b[d];
    { const int tq11 = opq(tid_);
      const LAS bf16_t* l00 = (const LAS bf16_t*)lds; const LAS bf16_t* l01 = l00 + 16384;
#pragma unroll
    for (int n1 = 0; n1 < 32; ++n1) { const int m = 512 * n1 + tq11;
        const float wMr = opqf(tw.wMr), wMi = opqf(tw.wMi); const float mr = wMr * C64[n1] + wMi * S64[n1], mi = wMi * C64[n1] - wMr * S64[n1];
        const float qr = x[n1].x * mr + x[n1].y * mi, qi = x[n1].y * mr - x[n1].x * mi;
        const f32x2 e = unpk(pk[n1]);
        const float sg = (n1 >= 16) ? 1.f : -1.f; const int t = (n1 >= 16) ? m - 8192 : m + 8192;
        const float y0 = (e.x + sg * qr) * (0.5f / 16384.0f), y1 = (e.y + sg * qi) * (0.5f / 16384.0f);
        const float g0 = conv3l(l00, t, pb0, pw0, pw1, pw2, pc0), g1 = conv3l(l01, t, pb0, pw0, pw1, pw2, pc0);
        o0[t] = f2bf(g0 * y0); o1[t] = f2bf(g1 * y1); }
    }
    __syncthreads();
}

__device__ __forceinline__ void conv_ctx_channel(int d, const bf16_t* projT, const float* filtC, const float* b_in, const float* conv_w, const float* conv_b, const float* hy_bias,
                                                 bf16_t* yT, LAS float* wl, int lane) {
    ConvCh p; load_ch(p, b_in, conv_w, conv_b, d);
    const bf16_t* r0 = projT + (size_t)d * TM + SEQ; const bf16_t* r1 = projT + (size_t)(D + d) * TM + SEQ; const bf16_t* rv = projT + (size_t)(2 * D + d) * TM + SEQ;
    LAS float* hl = wl; LAS float* z0 = wl + 256; LAS float* z1 = wl + 512;
    float hv[4]; float s = 0.f;
#pragma unroll
    for (int i = 0; i < 4; ++i) { hv[i] = filtC[(size_t)d * CTXL + 64 * i + lane]; s += fabsf(hv[i]); }
    s = wave_sum(s); const float scale = 1.0f / s; const float bias = hy_bias[d];
#pragma unroll
    for (int i = 0; i < 4; ++i) { const int n = 64 * i + lane; float h = hv[i] * scale; if (n == CTXL / 2) h += bias; hl[n] = h;
        z0[n] = conv3(rv, n, CTXL, p.bv, p.wv0, p.wv1, p.wv2, p.cv) * conv3(r1, n, CTXL, p.b1, p.w10, p.w11, p.w12, p.c1);
        z1[n] = conv3(rv + TB, n, CTXL, p.bv, p.wv0, p.wv1, p.wv2, p.cv) * conv3(r1 + TB, n, CTXL, p.b1, p.w10, p.w11, p.w12, p.c1); }
    asm volatile("s_waitcnt lgkmcnt(0)" ::: "memory");
    float a0[4] = {0.f, 0.f, 0.f, 0.f}, a1[4] = {0.f, 0.f, 0.f, 0.f};
    for (int j = 0; j < CTXL; ++j) { const float h = hl[j];
#pragma unroll
        for (int i = 0; i < 4; ++i) { const int q = 64 * i + lane + CTXL / 2 - j; const bool ok = (q >= 0) && (q < CTXL); const int qq = ok ? q : 0;
            const float v0 = z0[qq], v1 = z1[qq]; a0[i] += ok ? h * v0 : 0.f; a1[i] += ok ? h * v1 : 0.f; } }
    bf16_t* o0 = yT + (size_t)d * TM + SEQ; bf16_t* o1 = o0 + TB;
#pragma unroll
    for (int i = 0; i < 4; ++i) { const int t = 64 * i + lane;
        o0[t] = f2bf(conv3(r0, t, CTXL, p.b0, p.w00, p.w01, p.w02, p.c0) * a0[i]); o1[t] = f2bf(conv3(r0 + TB, t, CTXL, p.b0, p.w00, p.w01, p.w02, p.c0) * a1[i]); }
    asm volatile("s_waitcnt lgkmcnt(0)" ::: "memory");
}
}

struct CvtJob { const float* src; bf16_t* dst; int K, N, mode, start; };
constexpr int NJOBS = 24;
__device__ __forceinline__ unsigned f2bf_sw(float f) { unsigned u = __builtin_bit_cast(unsigned, f); return (u + 0x7fffu + ((u >> 16) & 1u)) >> 16; }
__device__ __forceinline__ unsigned pk2(float lo, float hi) { return f2bf_sw(lo) | (f2bf_sw(hi) << 16); }
struct CvtItem { const float* src; bf16_t* dst; int N, K; float sc; };
__device__ __forceinline__ void cvt_locate(const CvtJob& jb, int item, CvtItem& t) {
    const int nblk = jb.N / 64, kb = item / nblk, nb = item % nblk, k0 = 64 * kb, n0 = 64 * nb;
    const int rbase = (jb.mode == 0) ? n0 : ((n0 >> 7) * 256 + (n0 & 127) + (jb.mode == 2 ? 128 : 0));
    t.src = jb.src + (size_t)k0 * jb.N + n0; t.dst = jb.dst + (size_t)rbase * jb.K + k0; t.N = jb.N; t.K = jb.K; t.sc = (jb.mode == 1) ? -1.4426950408889634f : ((jb.mode == 2) ? -0.6931471805599453f : 1.0f);
}
__device__ __forceinline__ void cvt_load(const CvtItem& t, f32x4 (&v)[16], int lane) {
    const int c4 = lane & 15, kr = lane >> 4;
#pragma unroll
    for (int i = 0; i < 16; ++i) { const int k = 2 * (kr + 4 * (i >> 1)) + (i & 1); v[i] = *(const f32x4*)(t.src + (size_t)k * t.N + 4 * c4); }
}
__device__ __forceinline__ void cvt_store(const CvtItem& t, const f32x4 (&v)[16], LAS unsigned* scr, int lane) {
    const int c4 = lane & 15, kr = lane >> 4;
#pragma unroll
    for (int j = 0; j < 8; ++j)
#pragma unroll
        for (int c = 0; c < 4; ++c) scr[(4 * c4 + c) * 33 + kr + 4 * j] = cvt_pk_bf16(v[2 * j][c] * t.sc, v[2 * j + 1][c] * t.sc);
    asm volatile("s_waitcnt lgkmcnt(0)" ::: "memory");
    const int q = lane & 7;
#pragma unroll
    for (int i = 0; i < 8; ++i) { const int n = (lane >> 3) + 8 * i; const LAS unsigned* s = scr + n * 33 + 4 * q;
        u32x4 o; o.x = s[0]; o.y = s[1]; o.z = s[2]; o.w = s[3];
        *(u32x4*)(t.dst + (size_t)n * t.K + 8 * q) = o; }
    asm volatile("s_waitcnt lgkmcnt(0)" ::: "memory");
}

__device__ __forceinline__ void adaln_job(int job, const float* c, const float* c_ctx, const float* ada_w, const float* ada_b, float* mod, LAS unsigned char* lds, int tid) {
    LAS float* sv = (LAS float*)lds;
    LAS float* red = (LAS float*)(lds + 24576);
    const int layer = job >> 6, colbase = (job & 63) * 192;
    for (int i = tid; i < 3 * D; i += 512) { const int r = i / D, k = i % D; const float v = (r < 2) ? c[r * D + k] : c_ctx[k]; sv[i] = v / (1.0f + expf(-v)); }
    __syncthreads();
    const int cq = tid & 15, kg = tid >> 4;
    f32x4 a[3][3];
#pragma unroll
    for (int p = 0; p < 3; ++p)
#pragma unroll
        for (int r = 0; r < 3; ++r) a[p][r] = (f32x4){0.f, 0.f, 0.f, 0.f};
    const float* wp = ada_w + ((size_t)layer * D + (size_t)kg * 64) * MODW + colbase + cq * 4;
#pragma unroll 8
    for (int kk = 0; kk < 64; ++kk) { const f32x4 w0 = *(const f32x4*)(wp + (size_t)kk * MODW), w1 = *(const f32x4*)(wp + (size_t)kk * MODW + 64), w2 = *(const f32x4*)(wp + (size_t)kk * MODW + 128);
        const int k = kg * 64 + kk; const float s0 = sv[k], s1 = sv[D + k], s2 = sv[2 * D + k];
        a[0][0] += w0 * s0; a[0][1] += w0 * s1; a[0][2] += w0 * s2;
        a[1][0] += w1 * s0; a[1][1] += w1 * s1; a[1][2] += w1 * s2;
        a[2][0] += w2 * s0; a[2][1] += w2 * s1; a[2][2] += w2 * s2; }
#pragma unroll
    for (int p = 0; p < 3; ++p)
#pragma unroll
        for (int r = 0; r < 3; ++r)
#pragma unroll
            for (int j = 0; j < 4; ++j) red[(kg * 3 + r) * 192 + p * 64 + cq * 4 + j] = a[p][r][j];
    __syncthreads();
    for (int o = tid; o < 3 * 192; o += 512) { const int r = o / 192, cc = o % 192; float s = 0.f;
        for (int g = 0; g < 32; ++g) s += red[(g * 3 + r) * 192 + cc];
        const int n = colbase + cc;
        mod[((size_t)layer * 3 + r) * MODW + n] = s + ada_b[(size_t)layer * MODW + n]; }
    __syncthreads();
}

__device__ __forceinline__ void filter_job(int job, int Lf, const float* f_w_in, const float* f_w_hid, const float* f_b, const float* f_freq, const float* f_w_out, float* filtT,
                                           LAS unsigned char* lds, int tid) {
    LAS float* zb = (LAS float*)lds;
    LAS float* ga = zb + 64 * 33;
    LAS float* gb = ga + 64 * 65;
    LAS float* wl = gb + 64 * 65;
    LAS float* w_in = wl; LAS float* w_h = wl + 33 * 64; LAS float* bb = w_h + 2 * 64 * 64; LAS float* fq = bb + 192;
    const int p0 = job * 64;
    for (int i = tid; i < 33 * 64; i += 512) w_in[i] = f_w_in[i];
    for (int i = tid; i < 2 * 64 * 64; i += 512) w_h[i] = f_w_hid[i];
    if (tid < 192) { bb[tid] = f_b[tid]; fq[tid] = f_freq[tid]; }
    for (int i = tid; i < 64 * 33; i += 512) { const int pl = i / 33, k = i % 33; const float pos = (float)(p0 + pl); float v;
        if (k == 0) v = pos / (float)(Lf - 1);
        else { const int b = (k - 1) & 15; const float band = 1e-4f + (float)b * ((15.0f - 1e-4f) / 15.0f); const float ang = ((float)(6.283185307179586 / (double)Lf) * pos) * band;
               v = (k <= 16) ? cosf(ang) : -sinf(ang); }
        zb[i] = v; }
    __syncthreads();
    const int pl = tid >> 3, f0 = (tid & 7) * 8;
    { float a[8];
#pragma unroll
      for (int j = 0; j < 8; ++j) a[j] = 0.f;
#pragma unroll 1
      for (int k = 0; k < 33; ++k) { const float zv = zb[pl * 33 + k];
#pragma unroll
          for (int j = 0; j < 8; ++j) a[j] += zv * w_in[k * 64 + f0 + j]; }
#pragma unroll
      for (int j = 0; j < 8; ++j) ga[pl * 65 + f0 + j] = sinf(fq[f0 + j] * (a[j] + bb[f0 + j])); }
    __syncthreads();
    { float a[8];
#pragma unroll
      for (int j = 0; j < 8; ++j) a[j] = 0.f;
#pragma unroll 2
      for (int k = 0; k < 64; ++k) { const float gv = ga[pl * 65 + k];
#pragma unroll
          for (int j = 0; j < 8; ++j) a[j] += gv * w_h[k * 64 + f0 + j]; }
#pragma unroll
      for (int j = 0; j < 8; ++j) gb[pl * 65 + f0 + j] = sinf(fq[64 + f0 + j] * (a[j] + bb[64 + f0 + j])); }
    __syncthreads();
    { float a[8];
#pragma unroll
      for (int j = 0; j < 8; ++j) a[j] = 0.f;
#pragma unroll 2
      for (int k = 0; k < 64; ++k) { const float gv = gb[pl * 65 + k];
#pragma unroll
          for (int j = 0; j < 8; ++j) a[j] += gv * w_h[64 * 64 + k * 64 + f0 + j]; }
#pragma unroll
      for (int j = 0; j < 8; ++j) ga[pl * 65 + f0 + j] = sinf(fq[128 + f0 + j] * (a[j] + bb[128 + f0 + j])); }
    __syncthreads();
    { typedef float f32x16 __attribute__((ext_vector_type(16)));
      const int lane = tid & 63, wv = __builtin_amdgcn_readfirstlane(tid >> 6), li = lane & 31, lh = lane >> 5;
      const float invh = 1.0f / (float)(Lf / 2);
#define SPLIT8(V, HI, LO) do { u32x4 h_, l_; _Pragma("unroll") for (int q_ = 0; q_ < 4; ++q_) { const unsigned hp_ = cvt_pk_bf16((V)[2 * q_], (V)[2 * q_ + 1]); h_[q_] = hp_; \
          l_[q_] = cvt_pk_bf16((V)[2 * q_] - __uint_as_float(hp_ << 16), (V)[2 * q_ + 1] - __uint_as_float(hp_ & 0xffff0000u)); } (HI) = __builtin_bit_cast(bf16x8, h_); (LO) = __builtin_bit_cast(bf16x8, l_); } while (0)
      for (int t = 0; t < 2; ++t) {
          bf16x8 ah[4], al[4];
#pragma unroll
          for (int sk = 0; sk < 4; ++sk) { float v[8];
#pragma unroll
              for (int e = 0; e < 8; ++e) v[e] = ga[(32 * t + li) * 65 + 16 * sk + 8 * lh + e];
              SPLIT8(v, ah[sk], al[sk]); }
          for (int ct = 0; ct < 8; ++ct) { const int ch = 256 * wv + 32 * ct + li;
              bf16x8 bh[4], bl[4]; const float* wp = f_w_out + (size_t)(8 * lh) * D + ch;
#pragma unroll
              for (int sk = 0; sk < 4; ++sk) { float v[8];
#pragma unroll
                  for (int e = 0; e < 8; ++e) v[e] = wp[(size_t)(16 * sk + e) * D];
                  SPLIT8(v, bh[sk], bl[sk]); }
              f32x16 acc0 = {0.f, 0.f, 0.f, 0.f, 0.f, 0.f, 0.f, 0.f, 0.f, 0.f, 0.f, 0.f, 0.f, 0.f, 0.f, 0.f};
#pragma unroll
              for (int sk = 0; sk < 4; ++sk) { acc0 = __builtin_amdgcn_mfma_f32_32x32x16_bf16(al[sk], bh[sk], acc0, 0, 0, 0); acc0 = __builtin_amdgcn_mfma_f32_32x32x16_bf16(ah[sk], bl[sk], acc0, 0, 0, 0); }
#pragma unroll
              for (int sk = 0; sk < 4; ++sk) acc0 = __builtin_amdgcn_mfma_f32_32x32x16_bf16(ah[sk], bh[sk], acc0, 0, 0, 0);
              const float delta = fabsf(-3.070113457325394f + (float)ch * ((-15.350567286626971f + 3.070113457325394f) / 2047.0f));
#pragma unroll
              for (int g = 0; g < 4; ++g) { const int pp = p0 + 32 * t + 8 * g + 4 * lh; f32x4 o;
#pragma unroll
                  for (int e = 0; e < 4; ++e) { const float dist = fabsf((float)(pp + e - Lf / 2)) * invh; o[e] = acc0[4 * g + e] * expf(-dist * delta); }
                  *(f32x4*)(filtT + (size_t)ch * Lf + pp) = o; } } }
#undef SPLIT8
    }
    __syncthreads();
}

__device__ __forceinline__ void modulate_row(const float* src, const float* sh, const float* sc, bf16_t* dst, int lane) {
#pragma unroll
    for (int j = 0; j < 8; ++j) { const int c = lane * 4 + 256 * j; const f32x4 x = *(const f32x4*)(src + c), a = *(const f32x4*)(sc + c), b = *(const f32x4*)(sh + c);
        const f32x4 v = x * (a + 1.0f) + b; u32x2 w; w.x = cvt_pk_bf16(v[0], v[1]); w.y = cvt_pk_bf16(v[2], v[3]); *(u32x2*)(dst + c) = w; }
}
typedef _Float16 h16_t;
typedef _Float16 h16x4 __attribute__((ext_vector_type(4)));
__device__ __forceinline__ f32x4 ld_res4(const float* p) { return __builtin_nontemporal_load((const f32x4*)p); }
__device__ __forceinline__ f32x4 ld_res4(const h16_t* p) { return __builtin_convertvector(__builtin_nontemporal_load((const h16x4*)p), f32x4); }
__device__ __forceinline__ void st_res4(float* p, f32x4 v) { __builtin_nontemporal_store(v, (f32x4*)p); }
__device__ __forceinline__ void st_res4(h16_t* p, f32x4 v) { __builtin_nontemporal_store(__builtin_convertvector(v, h16x4), (h16x4*)p); }
__device__ __forceinline__ f32x4 ldp4(const float* p) { return *(const f32x4*)p; }
__device__ __forceinline__ f32x4 ldp4(const LAS float* p) { return *(const LAS f32x4*)p; }
template <typename RT, typename HT, int NP = 1, typename PP = const float*>
__device__ __forceinline__ void ln_row(const RT* resid, const bf16_t* y, PP gate, PP lg, PP lb, HT* hout, PP sh, PP sc, bf16_t* uout, int lane,
                                       const float* ybias = nullptr) {
    f32x4 z[8]; float s = 0.f;
#pragma unroll
    for (int j = 0; j < 8; ++j) { const int c = lane * 4 + 256 * j; const f32x4 r = ld_res4(resid + c), g = ldp4(gate + c);
        u32x2 yy[NP];
#pragma unroll
        for (int p = 0; p < NP; ++p) yy[p] = *(const u32x2*)(y + (size_t)p * D + c);
        f32x4 yv; yv[0] = __uint_as_float(yy[0].x << 16); yv[1] = __uint_as_float(yy[0].x & 0xffff0000u); yv[2] = __uint_as_float(yy[0].y << 16); yv[3] = __uint_as_float(yy[0].y & 0xffff0000u);
#pragma unroll
        for (int p = 1; p < NP; ++p) { yv[0] += __uint_as_float(yy[p].x << 16); yv[1] += __uint_as_float(yy[p].x & 0xffff0000u); yv[2] += __uint_as_float(yy[p].y << 16); yv[3] += __uint_as_float(yy[p].y & 0xffff0000u); }
        if (NP > 1 && ybias) yv += *(const f32x4*)(ybias + c);
        z[j] = r * ALPHA + g * yv; s += (z[j][0] + z[j][1]) + (z[j][2] + z[j][3]); }
    const float mean = wave_sum(s) * (1.0f / D); float q = 0.f;
#pragma unroll
    for (int j = 0; j < 8; ++j) { z[j] = z[j] - mean; q += (z[j][0] * z[j][0] + z[j][1] * z[j][1]) + (z[j][2] * z[j][2] + z[j][3] * z[j][3]); }
    const float rstd = 1.0f / sqrtf(wave_sum(q) * (1.0f / D) + LN_EPS);
#pragma unroll
    for (int j = 0; j < 8; ++j) { const int c = lane * 4 + 256 * j; const f32x4 g = ldp4(lg + c), b = ldp4(lb + c);
        const f32x4 h = z[j] * rstd * g + b; st_res4(hout + c, h);
        if (uout) { const f32x4 a = ldp4(sc + c), bs = ldp4(sh + c); const f32x4 v = h * (a + 1.0f) + bs;
            u32x2 w; w.x = cvt_pk_bf16(v[0], v[1]); w.y = cvt_pk_bf16(v[2], v[3]); *(u32x2*)(uout + c) = w; } }
}
__device__ __forceinline__ void mla_norm_row(int row, const bf16_t* cqkv, const float* q_norm, const float* kv_norm, const float* rope, bf16_t* cqn, bf16_t* ckvn, bf16_t* krope, int lane) {
    const bf16_t* src = cqkv + (size_t)row * 1280;
#pragma unroll
    for (int part = 0; part < 2; ++part) {
        const u32x4 raw = *(const u32x4*)(src + part * 512 + lane * 8); float x[8];
        x[0] = __uint_as_float(raw.x << 16); x[1] = __uint_as_float(raw.x & 0xffff0000u); x[2] = __uint_as_float(raw.y << 16); x[3] = __uint_as_float(raw.y & 0xffff0000u);
        x[4] = __uint_as_float(raw.z << 16); x[5] = __uint_as_float(raw.z & 0xffff0000u); x[6] = __uint_as_float(raw.w << 16); x[7] = __uint_as_float(raw.w & 0xffff0000u);
        float ss = 0.f;
#pragma unroll
        for (int j = 0; j < 8; ++j) ss += x[j] * x[j];
        const float r = 1.0f / sqrtf(wave_sum(ss) * (1.0f / 512.0f) + RMS_EPS);
        const float* gn = (part == 0 ? q_norm : kv_norm) + lane * 8; const f32x4 g0 = *(const f32x4*)gn, g1 = *(const f32x4*)(gn + 4);
        u32x4 o; o.x = cvt_pk_bf16(x[0] * r * g0[0], x[1] * r * g0[1]); o.y = cvt_pk_bf16(x[2] * r * g0[2], x[3] * r * g0[3]);
        o.z = cvt_pk_bf16(x[4] * r * g1[0], x[5] * r * g1[1]); o.w = cvt_pk_bf16(x[6] * r * g1[2], x[7] * r * g1[3]);
        *(u32x4*)((part == 0 ? cqn : ckvn) + (size_t)row * 512 + lane * 8) = o;
    }
    const float x = bf2f(src[1024 + lane]); const float xp = __shfl_xor(x, 16);
    const int t = row % TB; float outv = x;
    if (t < SEQ) { const int a = lane >> 5, half = (lane >> 4) & 1, p = lane & 15; const int pos = a ? (t & 63) : (t >> 6);
        const f32x2 cs = *(const f32x2*)(rope + (size_t)(pos * 16 + p) * 2);
        outv = half ? (x * cs.x + xp * cs.y) : (x * cs.x - xp * cs.y); }
    krope[(size_t)row * 64 + lane] = f2bf(outv);
}
__device__ __forceinline__ void pool_item(int item, const h16_t* __restrict__ h, const float* __restrict__ sc1, bf16_t* __restrict__ dout) {
    const int cq = item & 511, chunk = (item >> 9) & 127, b = item >> 16;
    const int c = cq * 4, g = c >> 9, hw = 1 << g;
    const h16_t* hb = h + (size_t)b * SEQ * D + c; const float* scp = sc1 + (size_t)b * MODW + c;
    const f32x4 mul = *(const f32x4*)scp + 1.0f;
    const int t0 = chunk * 128;
    f32x4 sum = {0.f, 0.f, 0.f, 0.f};
    for (int tt = t0 - hw; tt < t0 + hw; ++tt) { const int tc = tt < 0 ? 0 : (tt >= SEQ ? SEQ - 1 : tt); const float m = (tt >= 0 && tt < SEQ) ? 1.f : 0.f;
        sum += __builtin_convertvector(*(const h16x4*)(hb + (size_t)tc * D), f32x4) * m; }
    bf16_t* dp = dout + ((size_t)b * TB + t0) * D + c;
    for (int i0 = 0; i0 < 128; i0 += 8) {
        h16x4 cu[8], nx[8], pv[8];
#pragma unroll
        for (int k = 0; k < 8; ++k) { const int t = t0 + i0 + k, tn = (t + hw < SEQ) ? t + hw : SEQ - 1, tp = (t - hw >= 0) ? t - hw : 0;
            cu[k] = *(const h16x4*)(hb + (size_t)t * D); nx[k] = *(const h16x4*)(hb + (size_t)tn * D); pv[k] = *(const h16x4*)(hb + (size_t)tp * D); }
#pragma unroll
        for (int k = 0; k < 8; ++k) { const int t = t0 + i0 + k;
            const int lo = (t - hw) > 0 ? (t - hw) : 0, hi = (t + hw) < SEQ ? (t + hw) : SEQ;
            const f32x4 dv = (sum * (1.0f / (float)(hi - lo)) - __builtin_convertvector(cu[k], f32x4)) * mul;
            u32x2 w; w.x = cvt_pk_bf16(dv[0], dv[1]); w.y = cvt_pk_bf16(dv[2], dv[3]);
            *(u32x2*)(dp + (size_t)(i0 + k) * D) = w;
            const float mn = (t + hw < SEQ) ? 1.f : 0.f, mp = (t - hw >= 0) ? 1.f : 0.f;
            sum += __builtin_convertvector(nx[k], f32x4) * mn - __builtin_convertvector(pv[k], f32x4) * mp; }
    }
}
__device__ __forceinline__ void transpose_tile(const bf16_t* src, bf16_t* dst, int d0, int t0, LAS unsigned* scr, int lane) {
#pragma unroll 8
    for (int i = 0; i < 32; ++i) { const int r = 2 * i + (lane >> 5); scr[r * 33 + (lane & 31)] = *(const unsigned*)(src + (size_t)(d0 + r) * TM + t0 + 2 * (lane & 31)); }
    asm volatile("s_waitcnt lgkmcnt(0)" ::: "memory");
    const LAS bf16_t* s16 = (const LAS bf16_t*)scr;
#pragma unroll 8
    for (int i = 0; i < 32; ++i) { const int tr = 2 * i + (lane >> 5), dp = lane & 31;
        const unsigned lo = s16[(2 * dp) * 66 + tr], hi = s16[(2 * dp + 1) * 66 + tr];
        *(unsigned*)(dst + (size_t)(t0 + tr) * D + d0 + 2 * dp) = lo | (hi << 16); }
    asm volatile("s_waitcnt lgkmcnt(0)" ::: "memory");
}

constexpr size_t MiB = 1u << 20;
constexpr size_t WS_CTL = 0;
constexpr size_t WS_MOD = 1 * MiB;
constexpr size_t WS_ROPE = 2 * MiB;
constexpr size_t WS_FILTC = 3 * MiB;
constexpr size_t WS_HC = 5 * MiB;
constexpr size_t WS_W = 16 * MiB;
constexpr size_t SZ_WGU = (size_t)2 * DFF * D * 2, SZ_WD = (size_t)D * DFF * 2, SZ_HYIN = (size_t)3 * D * D * 2, SZ_DD = (size_t)D * D * 2;
constexpr size_t WS_WGU = WS_W, WS_WD = WS_WGU + 4 * SZ_WGU, WS_HYIN = WS_WD + 4 * SZ_WD, WS_HYOUT = WS_HYIN + 2 * SZ_HYIN;
constexpr size_t WS_MWIN = WS_HYOUT + 2 * SZ_DD, WS_MWQB = WS_MWIN + (size_t)1280 * D * 2, WS_MWKVB = WS_MWQB + (size_t)3072 * 512 * 2, WS_MWOUT = WS_MWKVB + (size_t)4096 * 512 * 2;
constexpr size_t WS_POOLW = WS_MWOUT + SZ_DD, WS_WEND = WS_POOLW + (size_t)D * 512 * 2;
static_assert(WS_WEND == 366 * MiB, "weight region");
constexpr size_t SZ_ROWS = (size_t)TM * D * 2;
constexpr size_t WS_U = 366 * MiB, WS_Y = WS_U + SZ_ROWS, WS_YMIX = WS_Y + SZ_ROWS, WS_FFT = WS_YMIX + SZ_ROWS;
static_assert(SZ_ROWS == 130 * MiB, "row buffer");
constexpr size_t FFT_SCR = (size_t)2 * 32 * 512 * 4;
constexpr size_t WS_BIG = WS_FFT + 256 * FFT_SCR;
constexpr size_t BIG_PROJT = 0, BIG_YT = (size_t)3 * D * TM * 2;
constexpr size_t BIG_MID = 0;
constexpr size_t BIG_CQKV = 0, BIG_CQN = BIG_CQKV + (size_t)TM * 1280 * 2, BIG_CKVN = BIG_CQN + (size_t)TM * 512 * 2, BIG_KROPE = BIG_CKVN + (size_t)TM * 512 * 2;
constexpr size_t BIG_Q = BIG_KROPE + (size_t)TM * 64 * 2, BIG_KV = BIG_Q + (size_t)TM * 3072 * 2, BIG_END = BIG_KV + (size_t)TM * 4096 * 2;
static_assert(BIG_YT + SZ_ROWS <= BIG_END && (size_t)TM * DFF * 2 <= BIG_END, "big region");
constexpr size_t WS_H16 = (WS_BIG + BIG_END + MiB - 1) / MiB * MiB;
constexpr size_t WS_END = WS_H16 + (size_t)NBATCH * SEQ * D * 2;
static_assert(WS_END <= (size_t)1610612736, "workspace budget (4 x largest input = 1.5 GiB)");
static_assert((size_t)D * SEQ * 4 <= SZ_ROWS, "filtT overlays YMIX");

constexpr int LDS_PHASE_BYTES = 150528;  static_assert(att16::SHM_ATTN <= LDS_PHASE_BYTES, "attention LDS");
constexpr int LDS_MISC_OFF = LDS_PHASE_BYTES;
constexpr int LDS_BYTES = 151552;
static_assert(LDS_MISC_OFF + 64 <= LDS_BYTES, "LDS map");

#ifndef FFN_UP_ALIGN
#define FFN_UP_ALIGN true
#endif
#ifndef SHORTK_ALIGN
#define SHORTK_ALIGN true
#endif
#ifndef ATTN_NS
#define ATTN_NS att16
#endif
constexpr int NPHASE = 33;
constexpr int KS_OUT = 8, KS_DOWN = 11;
static_assert((size_t)2 * CTXL * KS_DOWN * D * 2 <= 256 * FFT_SCR && D % (KS_OUT * 128) == 0 && DFF % (KS_DOWN * 128) == 0, "context split-K");
struct Params {
    const float* in[31];
    float* out;
    unsigned char* ws;
    int ph_lo, ph_hi;
    CvtJob jobs[NJOBS];
    int njobs_items, pad;
};

__global__ void __launch_bounds__(512, 2) mega_fwd(Params P) {
    extern __shared__ __attribute__((aligned(16))) unsigned char lds_raw[];
    LAS unsigned char* lds = (LAS unsigned char*)lds_raw;
    const int tid = threadIdx.x, lane = tid & 63, wave = __builtin_amdgcn_readfirstlane(tid >> 6);
    const int G = gridDim.x, bx = blockIdx.x;
    const int vcu = (G % 8 == 0) ? (bx % 8) * (G / 8) + bx / 8 : bx;
    const int gw = vcu * 8 + wave, NGW = G * 8;
    unsigned char* ws = P.ws;
    volatile LAS unsigned* MISC = (volatile LAS unsigned*)(lds + LDS_MISC_OFF);
    if (tid < 16) MISC[tid] = 0u;
    __syncthreads();
    XcdBarrier bar = xcd_barrier_post((unsigned*)(ws + WS_CTL) + 4096, MISC + 8);
    const int lo = P.ph_lo, hi = P.ph_hi;
#define IN(k) (lo <= (k) && (k) < hi)
#ifdef PROBE_BAR2
#define SEAM(k) do { if (IN(k) && IN((k) + 1)) { xcd_barrier(bar); xcd_barrier(bar); } } while (0)
#else
#define SEAM(k) do { if (IN(k) && IN((k) + 1)) xcd_barrier(bar); } while (0)
#endif
#ifndef PROBE_MASK
#define PROBE_MASK 0ull
#endif
#define REP(k) for (int rep_ = 0; rep_ < ((((unsigned long long)(PROBE_MASK) >> (k)) & 1ull) ? 2 : 1); ++rep_)

    const float* x = P.in[0]; const float* cvec = P.in[1]; const float* ctx = P.in[2]; const float* c_ctx = P.in[3];
    const float* ada_w = P.in[4]; const float* ada_b = P.in[5]; const float* ln_g = P.in[6]; const float* ln_b = P.in[7];
    const float* hy_b_in = P.in[12]; const float* hy_conv_w = P.in[13]; const float* hy_conv_b = P.in[14];
    const float* hy_f_w_in = P.in[15]; const float* hy_f_w_hid = P.in[16]; const float* hy_f_b = P.in[17]; const float* hy_f_freq = P.in[18]; const float* hy_f_w_out = P.in[19];
    const float* hy_bias = P.in[20]; const float* hy_b_out = P.in[22];
    const float* mla_q_norm = P.in[24]; const float* mla_kv_norm = P.in[25]; const float* pool_scale = P.in[30];
    float* out = P.out;
    float* mod = (float*)(ws + WS_MOD); float* rope = (float*)(ws + WS_ROPE); float* filtC = (float*)(ws + WS_FILTC); float* HC = (float*)(ws + WS_HC);
    bf16_t* Wgu = (bf16_t*)(ws + WS_WGU); bf16_t* Wd = (bf16_t*)(ws + WS_WD); bf16_t* HyIn = (bf16_t*)(ws + WS_HYIN); bf16_t* HyOut = (bf16_t*)(ws + WS_HYOUT);
    bf16_t* MWin = (bf16_t*)(ws + WS_MWIN); bf16_t* MWqb = (bf16_t*)(ws + WS_MWQB); bf16_t* MWkvb = (bf16_t*)(ws + WS_MWKVB); bf16_t* MWout = (bf16_t*)(ws + WS_MWOUT); bf16_t* PoolW = (bf16_t*)(ws + WS_POOLW);
    bf16_t* U = (bf16_t*)(ws + WS_U); bf16_t* Y = (bf16_t*)(ws + WS_Y); bf16_t* YMIX = (bf16_t*)(ws + WS_YMIX); float* filtT = (float*)(ws + WS_YMIX);
    h16_t* H16 = (h16_t*)(ws + WS_H16);
    float* filtT3 = out;
    unsigned char* big = ws + WS_BIG;
    bf16_t* projT = (bf16_t*)(big + BIG_PROJT); bf16_t* yT = (bf16_t*)(big + BIG_YT); bf16_t* mid = (bf16_t*)(big + BIG_MID);
    bf16_t* cqkv = (bf16_t*)(big + BIG_CQKV); bf16_t* cqn = (bf16_t*)(big + BIG_CQN); bf16_t* ckvn = (bf16_t*)(big + BIG_CKVN); bf16_t* krope = (bf16_t*)(big + BIG_KROPE);
    bf16_t* qbuf = (bf16_t*)(big + BIG_Q); bf16_t* kvbuf = (bf16_t*)(big + BIG_KV);
    unsigned* fftscr = (unsigned*)(ws + WS_FFT + (size_t)bx * FFT_SCR);
    bf16_t* YC = (bf16_t*)(ws + WS_FFT);
#define MODP(layer, r, chunk) (mod + ((size_t)(layer) * 3 + (r)) * MODW + (size_t)(chunk) * D)

#define GEMM_PLAIN_T(ALIGN_, Aptr, lda_, Btptr, ldb_, K_, nM_, nN_, skipM_, skipN_, grp_, Optr, ldc_, biasp, scalep) do { \
        pg8::Gemm g_{(Aptr), (Btptr), (lda_), (ldb_), (K_)}; pg8::Order S_; S_.init((nM_), (nN_), G, bx, (skipM_), (skipN_), (grp_)); \
        pg8::EpiPlain E_{(Optr), (ldc_), (biasp), (scalep)}; pg8::gemm_phase<pg8::EpiPlain, ALIGN_>(lds, g_, S_, E_); } while (0)
#define GEMM_PLAIN(...) GEMM_PLAIN_T(true, __VA_ARGS__)
#define LN_PHASE(layer, which, resid_main, hout_main, resid_ctx, with_ctx, next_u) do { \
        const int gch_ = (which) ? 5 : 2; const int nl_ = (which) ? (layer) + 1 : (layer); const int shc_ = (which) ? 0 : 3; \
        const float* lg_ = ln_g + ((size_t)(layer) * 2 + (which)) * D; const float* lb_ = ln_b + ((size_t)(layer) * 2 + (which)) * D; \
          \
        LAS float* lp_ = (LAS float*)lds; \
        { *(LAS f32x4*)(lp_ + 0 * D + 4 * tid) = *(const f32x4*)(MODP(layer, 0, gch_) + 4 * tid); *(LAS f32x4*)(lp_ + 1 * D + 4 * tid) = *(const f32x4*)(MODP(layer, 1, gch_) + 4 * tid); \
          *(LAS f32x4*)(lp_ + 2 * D + 4 * tid) = *(const f32x4*)(lg_ + 4 * tid); *(LAS f32x4*)(lp_ + 3 * D + 4 * tid) = *(const f32x4*)(lb_ + 4 * tid); \
          if (next_u) { *(LAS f32x4*)(lp_ + 4 * D + 4 * tid) = *(const f32x4*)(MODP(nl_, 0, shc_) + 4 * tid); *(LAS f32x4*)(lp_ + 5 * D + 4 * tid) = *(const f32x4*)(MODP(nl_, 1, shc_) + 4 * tid); \
                        *(LAS f32x4*)(lp_ + 6 * D + 4 * tid) = *(const f32x4*)(MODP(nl_, 0, shc_ + 1) + 4 * tid); *(LAS f32x4*)(lp_ + 7 * D + 4 * tid) = *(const f32x4*)(MODP(nl_, 1, shc_ + 1) + 4 * tid); } } \
        __syncthreads(); \
        for (int row = gw; row < TM; row += NGW) { const int b_ = row / TB, t_ = row % TB; \
            if (t_ < SEQ) { const size_t r_ = (size_t)b_ * SEQ + t_; \
                ln_row<__typeof__(*(resid_main) + 0), __typeof__(*(hout_main) + 0), 1, const LAS float*>((resid_main) + r_ * D, YMIX + (size_t)row * D, lp_ + b_ * D, lp_ + 2 * D, lp_ + 3 * D, (hout_main) + r_ * D, \
                       lp_ + (4 + b_) * D, lp_ + (6 + b_) * D, (next_u) ? U + (size_t)row * D : nullptr, lane); } \
            else if (with_ctx) { const size_t r_ = (size_t)b_ * CTXL + (t_ - SEQ); constexpr int np_ = (which) ? KS_DOWN : KS_OUT; \
                ln_row<float, float, np_, const float*>((resid_ctx) + r_ * D, YC + r_ * (size_t)(np_ * D), MODP(layer, 2, gch_), lg_, lb_, HC + r_ * D, \
                       (next_u) ? MODP(nl_, 2, shc_) : nullptr, (next_u) ? MODP(nl_, 2, shc_ + 1) : nullptr, (next_u) ? U + (size_t)row * D : nullptr, lane, (which) ? nullptr : hy_b_out); } } } while (0)
#define FFN_UP(layer, nM_, skip_) do { pg8::Gemm g_{U, Wgu + (size_t)(layer) * 2 * DFF * D, D, D, D}; pg8::Order S_; S_.init((nM_), 2 * DFF / 256, G, bx, (skip_), 0, 0); \
        pg8::EpiSwiglu E_{mid, DFF}; pg8::gemm_phase<pg8::EpiSwiglu, FFN_UP_ALIGN>(lds, g_, S_, E_); } while (0)
#define FFN_DOWN(layer, nM_, skip_) GEMM_PLAIN(mid, DFF, Wd + (size_t)(layer) * D * DFF, DFF, DFF, (nM_), D / 256, (skip_), 0, 0, YMIX, D, nullptr, nullptr)
#define GEMM_CTX_SPLITK(Aptr, lda_, Btptr, K_, ks_) do { pg8::Gemm g_{(Aptr) + (size_t)SEQ * (lda_), (Btptr), (lda_), (lda_), (K_) / (ks_)}; pg8::Order S_; S_.init_splitk(2, D / 256, (ks_), (K_) / (ks_), TB / 256, G, bx); \
        pg8::EpiPlain E_{YC, (ks_) * D, nullptr, nullptr}; pg8::gemm_phase<pg8::EpiPlain>(lds, g_, S_, E_); } while (0)
#define FILTER_JOBS(j, Lf_, dstp, first_job, njobs_) do { for (int jb_ = bx; jb_ < (njobs_); jb_ += G) \
        filter_job(jb_ + (first_job), (Lf_), hy_f_w_in + (size_t)(j) * 33 * 64, hy_f_w_hid + (size_t)(j) * 2 * 64 * 64, hy_f_b + (size_t)(j) * 192, hy_f_freq + (size_t)(j) * 192, \
                   hy_f_w_out + (size_t)(j) * 64 * D, (dstp), lds, tid); } while (0)
#ifndef FFT_PRIO
#define FFT_PRIO 1
#endif
#if FFT_PRIO
#define FFT_PRIO_ON do { if (wave < 4) __builtin_amdgcn_s_setprio(2); } while (0)
#define FFT_PRIO_OFF __builtin_amdgcn_s_setprio(0)
#else
#define FFT_PRIO_ON do {} while (0)
#define FFT_PRIO_OFF do {} while (0)
#endif
#define HYENA_CONV(j, filtp) do { FFT_PRIO_ON; fft::Tw tw_; fft::tw_init(tw_, tid); float hn_[32]; if (bx < D) { _Pragma("unroll") for (int n1_ = 0; n1_ < 32; ++n1_) hn_[n1_] = (filtp)[(size_t)bx * SEQ + 512 * n1_ + tid]; } \
        for (int d_ = bx; d_ < D; d_ += G) \
        fft::conv_channel(d_, projT, (filtp), hy_b_in + (size_t)(j) * 3 * D, hy_conv_w + (size_t)(j) * 9 * D, hy_conv_b + (size_t)(j) * 3 * D, hy_bias + (size_t)(j) * D, yT, fftscr, lds, tw_, tid, hn_, d_ + G); FFT_PRIO_OFF; } while (0)

    if (IN(0)) REP(0) {
        { LAS unsigned* scr = (LAS unsigned*)(lds + wave * 8448);
          int j = 0; CvtItem cur, nxt; f32x4 va[16], vb[16];
          int it = gw; const int nit = P.njobs_items;
          if (it < nit) { while (j + 1 < NJOBS && it >= P.jobs[j + 1].start) ++j; cvt_locate(P.jobs[j], it - P.jobs[j].start, cur); cvt_load(cur, va, lane); }
          while (it < nit) {
              int it2 = it + NGW; const bool h2 = it2 < nit;
              if (h2) { while (j + 1 < NJOBS && it2 >= P.jobs[j + 1].start) ++j; cvt_locate(P.jobs[j], it2 - P.jobs[j].start, nxt); cvt_load(nxt, vb, lane); }
              cvt_store(cur, va, scr, lane);
              if (!h2) break;
              int it3 = it2 + NGW; const bool h3 = it3 < nit;
              if (h3) { while (j + 1 < NJOBS && it3 >= P.jobs[j + 1].start) ++j; cvt_locate(P.jobs[j], it3 - P.jobs[j].start, cur); cvt_load(cur, va, lane); }
              cvt_store(nxt, vb, scr, lane);
              if (!h3) break;
              it = it3; }
          for (size_t i = (size_t)bx * 512 + tid; i < (size_t)(1280 - 1088) * D / 8; i += (size_t)G * 512) *(u32x4*)(MWin + (size_t)1088 * D + i * 8) = (u32x4){0u, 0u, 0u, 0u}; }
        __syncthreads();
        for (int jb = bx; jb < 256; jb += G) adaln_job(jb, cvec, c_ctx, ada_w, ada_b, mod, lds, tid);
        for (int i = bx * 512 + tid; i < 256 * 16; i += G * 512) { const int pos = i >> 4, p = i & 15; const float inv = powf(10000.0f, -(float)p / 16.0f); const float ang = (float)pos * inv;
            rope[2 * i] = cosf(ang); rope[2 * i + 1] = sinf(ang); }
        __syncthreads();
    }
    SEAM(0);
    if (IN(1)) REP(1) {
        for (int row = gw; row < TM; row += NGW) { const int b = row / TB, t = row % TB;
            if (t < SEQ) modulate_row(x + ((size_t)b * SEQ + t) * D, MODP(0, b, 0), MODP(0, b, 1), U + (size_t)row * D, lane);
            else modulate_row(ctx + ((size_t)b * CTXL + (t - SEQ)) * D, MODP(0, 2, 0), MODP(0, 2, 1), U + (size_t)row * D, lane); }
    }
    SEAM(1);
    if (IN(2)) REP(2) { GEMM_PLAIN(HyIn, D, U, D, D, 3 * D / 256, TM / 256, 0, 0, 0, projT, TM, nullptr, nullptr);
        { const int nwg_ = (3 * D / 256) * (TM / 256), rem_ = nwg_ % G, idle_ = G - rem_, k_ = (bx - rem_ + G) % G;
          if (k_ < idle_) for (int jb_ = k_; jb_ < 260; jb_ += idle_) {
              if (jb_ < 256) filter_job(jb_, SEQ, hy_f_w_in, hy_f_w_hid, hy_f_b, hy_f_freq, hy_f_w_out, filtT, lds, tid);
              else filter_job(jb_ - 256, CTXL, hy_f_w_in, hy_f_w_hid, hy_f_b, hy_f_freq, hy_f_w_out, filtC, lds, tid); } } }
    SEAM(2);
    if (IN(3)) REP(3) { HYENA_CONV(0, filtT);
        { LAS float* wl = (LAS float*)(lds + wave * 3072);
          for (int d = gw; d < D; d += NGW) fft::conv_ctx_channel(d, projT, filtC, hy_b_in, hy_conv_w, hy_conv_b, hy_bias, yT, wl, lane); } }
    SEAM(3);
    if (IN(4)) REP(4) { LAS unsigned* scr = (LAS unsigned*)(lds + wave * 8448);
        for (int tl = gw; tl < (D / 64) * (TM / 64); tl += NGW) transpose_tile(yT, Y, (tl % (D / 64)) * 64, (tl / (D / 64)) * 64, scr, lane); }
    SEAM(4);
    if (IN(5)) REP(5) { GEMM_PLAIN(Y, D, HyOut, D, D, 128, D / 256, 1, 0, 0, YMIX, D, hy_b_out, nullptr); GEMM_CTX_SPLITK(Y, D, HyOut, D, KS_OUT); }
    SEAM(5);
    if (IN(6)) REP(6) LN_PHASE(0, 0, x, H16, ctx, true, true);
    SEAM(6);
    if (IN(7)) REP(7) { FFN_UP(0, TM / 256, 0);
        { const int nwg_ = (TM / 256) * (2 * DFF / 256), rem_ = nwg_ % G, idle_ = G - rem_, k_ = (bx - rem_ + G) % G;
          if (k_ < idle_) for (int jb_ = k_; jb_ < 256; jb_ += idle_)
              filter_job(jb_, SEQ, hy_f_w_in + (size_t)33 * 64, hy_f_w_hid + (size_t)2 * 64 * 64, hy_f_b + 192, hy_f_freq + 192, hy_f_w_out + (size_t)64 * D, filtT3, lds, tid); } }
    SEAM(7);
    if (IN(8)) REP(8) { FFN_DOWN(0, 128, 1); GEMM_CTX_SPLITK(mid, DFF, Wd, DFF, KS_DOWN); }
    SEAM(8);
    if (IN(9)) REP(9) LN_PHASE(0, 1, H16, H16, HC, true, true);
    SEAM(9);
    if (IN(10)) REP(10) GEMM_PLAIN(U, D, MWin, D, D, TM / 256, 1280 / 256, 0, 0, 0, cqkv, 1280, nullptr, nullptr);
    SEAM(10);
    if (IN(11)) REP(11) { for (int row = gw; row < TM; row += NGW) mla_norm_row(row, cqkv, mla_q_norm, mla_kv_norm, rope, cqn, ckvn, krope, lane); }
    SEAM(11);
    if (IN(12)) REP(12) {
        { pg8::Gemm g_{cqn, MWqb, 512, 512, 512}; pg8::Order S_; S_.init(128, 3072 / 256, G, bx, 1, 0, 0); pg8::EpiQRope E_{qbuf, 3072, rope, att16::QSCALE}; pg8::gemm_phase<pg8::EpiQRope, SHORTK_ALIGN>(lds, g_, S_, E_); }
        GEMM_PLAIN_T(SHORTK_ALIGN, ckvn, 512, MWkvb, 512, 512, TM / 256, 4096 / 256, 0, 0, 0, kvbuf, 4096, nullptr, nullptr);
    }
    SEAM(12);
    if (IN(13)) REP(13) {
        for (int u = vcu; u < NBATCH * 16 * 64; u += G) { const int qb = u & 63, h = (u >> 6) & 15, b = u >> 10;
            __syncthreads();
            att16::attn_body(qbuf + ((size_t)b * TB + (size_t)qb * 256) * 3072 + h * 192, kvbuf + (size_t)b * TB * 4096 + h * 256, kvbuf + (size_t)b * TB * 4096 + h * 256 + 128,
                           krope + (size_t)b * TB * 64, Y + ((size_t)b * TB + (size_t)qb * 256) * D + h * 128, TB, (char*)lds_raw); }
    }
    SEAM(13);
    if (IN(14)) REP(14) GEMM_PLAIN(Y, D, MWout, D, D, 128, D / 256, 1, 0, 0, YMIX, D, nullptr, nullptr);
    SEAM(14);
    if (IN(15)) REP(15) LN_PHASE(1, 0, H16, H16, HC, false, true);
    SEAM(15);
    if (IN(16)) REP(16) FFN_UP(1, 128, 1);
    SEAM(16);
    if (IN(17)) REP(17) FFN_DOWN(1, 128, 1);
    SEAM(17);
    if (IN(18)) REP(18) LN_PHASE(1, 1, H16, H16, HC, false, false);
    SEAM(18);
    if (IN(19)) REP(19) { for (int it = bx * 512 + tid; it < NBATCH * 128 * 512; it += G * 512) pool_item(it, H16, MODP(2, 0, 1), Y); }
    SEAM(19);
    if (IN(20)) REP(20) GEMM_PLAIN(Y, D, PoolW, 512, 512, 128, D / 256, 1, 0, 1, YMIX, D, nullptr, pool_scale);
    SEAM(20);
    if (IN(21)) REP(21) LN_PHASE(2, 0, H16, H16, HC, false, true);
    SEAM(21);
    if (IN(22)) REP(22) FFN_UP(2, 128, 1);
    SEAM(22);
    if (IN(23)) REP(23) FFN_DOWN(2, 128, 1);
    SEAM(23);
    if (IN(24)) REP(24) LN_PHASE(2, 1, H16, H16, HC, false, true);
    SEAM(24);
    if (IN(25)) REP(25) { GEMM_PLAIN(HyIn + (size_t)3 * D * D, D, U, D, D, 3 * D / 256, 128, 0, 1, 0, projT, TM, nullptr, nullptr);
    }
    SEAM(25);
    if (IN(26)) REP(26) HYENA_CONV(1, filtT3);
    SEAM(26);
    if (IN(27)) REP(27) { LAS unsigned* scr = (LAS unsigned*)(lds + wave * 8448);
        for (int tl = gw; tl < (D / 64) * (TM / 64); tl += NGW) { const int t0 = (tl / (D / 64)) * 64; if ((t0 % TB) < SEQ) transpose_tile(yT, Y, (tl % (D / 64)) * 64, t0, scr, lane); } }
    SEAM(27);
    if (IN(28)) REP(28) GEMM_PLAIN(Y, D, HyOut + (size_t)D * D, D, D, 128, D / 256, 1, 0, 0, YMIX, D, hy_b_out + D, nullptr);
    SEAM(28);
    if (IN(29)) REP(29) LN_PHASE(3, 0, H16, H16, HC, false, true);
    SEAM(29);
    if (IN(30)) REP(30) FFN_UP(3, 128, 1);
    SEAM(30);
    if (IN(31)) REP(31) FFN_DOWN(3, 128, 1);
    SEAM(31);
    if (IN(32)) REP(32) LN_PHASE(3, 1, H16, out, HC, false, false);
#undef IN
#undef SEAM
}

#ifndef MK_SINGLE
#define MK_SINGLE 1
#endif
extern "C" void kernel_launch(void* const* d_in, const int* in_sizes, int n_in, void* d_out, int out_size, void* d_ws, size_t ws_size, hipStream_t stream) {
    static int grid = 0;
    if (grid == 0) {
        if (n_in != 31 || out_size != NBATCH * SEQ * D || ws_size < WS_END) { fprintf(stderr, "kernel_launch: unexpected problem: n_in %d out %d ws %zu (need %zu)\n", n_in, out_size, ws_size, (size_t)WS_END); grid = -1; return; }
        int dev = 0, cus = 0, per_cu = 0;
        if (hipGetDevice(&dev) != hipSuccess || hipDeviceGetAttribute(&cus, hipDeviceAttributeMultiprocessorCount, dev) != hipSuccess) { grid = -1; return; }
        if (hipFuncSetAttribute((const void*)mega_fwd, hipFuncAttributeMaxDynamicSharedMemorySize, LDS_BYTES) != hipSuccess) { fprintf(stderr, "kernel_launch: hipFuncSetAttribute failed\n"); grid = -1; return; }
        if (hipOccupancyMaxActiveBlocksPerMultiprocessor(&per_cu, (const void*)mega_fwd, 512, LDS_BYTES) != hipSuccess || per_cu < 1) fprintf(stderr, "kernel_launch: occupancy query says %d\n", per_cu);
        (void)hipGetLastError();
        grid = cus < 256 ? cus : 256;
    }
    if (grid < 0) return;
    (void)hipMemsetAsync((char*)d_ws + WS_CTL, 0, 1 * MiB, stream);
    Params P{};
    for (int i = 0; i < 31; ++i) P.in[i] = (const float*)d_in[i];
    P.out = (float*)d_out; P.ws = (unsigned char*)d_ws;
    unsigned char* ws = (unsigned char*)d_ws;
    int nj = 0, items = 0;
    auto add = [&](const float* src, size_t dst_off, int K, int N, int mode) { P.jobs[nj].src = src; P.jobs[nj].dst = (bf16_t*)(ws + dst_off); P.jobs[nj].K = K; P.jobs[nj].N = N; P.jobs[nj].mode = mode; P.jobs[nj].start = items; items += (K / 64) * (N / 64); ++nj; };
    for (int i = 0; i < 4; ++i) {
        add(P.in[8] + (size_t)i * D * DFF, WS_WGU + i * SZ_WGU, D, DFF, 1);
        add(P.in[9] + (size_t)i * D * DFF, WS_WGU + i * SZ_WGU, D, DFF, 2);
        add(P.in[10] + (size_t)i * DFF * D, WS_WD + i * SZ_WD, DFF, D, 0);
    }
    for (int j = 0; j < 2; ++j) { add(P.in[11] + (size_t)j * D * 3 * D, WS_HYIN + j * SZ_HYIN, D, 3 * D, 0); add(P.in[21] + (size_t)j * D * D, WS_HYOUT + j * SZ_DD, D, D, 0); }
    add(P.in[23], WS_MWIN, D, 1088, 0); add(P.in[26], WS_MWQB, 512, 3072, 0); add(P.in[27], WS_MWKVB, 512, 4096, 0); add(P.in[28], WS_MWOUT, D, D, 0);
    for (int g = 0; g < 4; ++g) add(P.in[29] + (size_t)g * 512 * 512, WS_POOLW + (size_t)g * 512 * 512 * 2, 512, 512, 0);
    P.njobs_items = items; P.pad = 0;
#if MK_SINGLE
#ifdef PROBE_EXTRA
    { const int extra[] = {PROBE_EXTRA}; for (int k : extra) { P.ph_lo = k; P.ph_hi = k + 1; hipLaunchKernelGGL(mega_fwd, dim3(grid), dim3(512), LDS_BYTES, stream, P); }
      (void)hipMemsetAsync((char*)d_ws + WS_CTL, 0, 1 * MiB, stream); }
#endif
    P.ph_lo = 0; P.ph_hi = NPHASE;
    hipLaunchKernelGGL(mega_fwd, dim3(grid), dim3(512), LDS_BYTES, stream, P);
#ifdef PROBE_POST
    { const int extra[] = {PROBE_POST}; for (int k : extra) { P.ph_lo = k; P.ph_hi = k + 1; hipLaunchKernelGGL(mega_fwd, dim3(grid), dim3(512), LDS_BYTES, stream, P); } }
#endif
#else
    for (int k = 0; k < NPHASE; ++k) { P.ph_lo = k; P.ph_hi = k + 1; hipLaunchKernelGGL(mega_fwd, dim3(grid), dim3(512), LDS_BYTES, stream, P); }
#endif
    const hipError_t le = hipPeekAtLastError();
    if (le != hipSuccess) fprintf(stderr, "kernel_launch: launch failed: %s\n", hipGetErrorName(le));
}
```

```cpp
#include <hip/hip_runtime.h>
#define MK_SINGLE 1
#include <cstdio>
#include <cstdint>

constexpr int D = 2048, DFF = 5632, SEQ = 16384, CTXL = 256, NBATCH = 2;
constexpr int TB = SEQ + CTXL;
constexpr int TM = NBATCH * TB;
constexpr float ALPHA = 1.681792830507429f;
constexpr float LN_EPS = 1e-6f, RMS_EPS = 1e-6f;
constexpr int MODW = 6 * D;

#define GAS __attribute__((address_space(1)))
#define LAS __attribute__((address_space(3)))
typedef unsigned short bf16_t;
typedef short bf16x8 __attribute__((ext_vector_type(8)));
typedef float f32x4 __attribute__((ext_vector_type(4)));
typedef float f32x2 __attribute__((ext_vector_type(2)));
typedef unsigned u32x4 __attribute__((ext_vector_type(4)));
typedef unsigned u32x2 __attribute__((ext_vector_type(2)));

__device__ __forceinline__ float bf2f(bf16_t v) { return __uint_as_float(((unsigned)v) << 16); }
__device__ __forceinline__ unsigned cvt_pk_bf16(float lo, float hi) { unsigned r; asm volatile("v_cvt_pk_bf16_f32 %0, %1, %2" : "=v"(r) : "v"(lo), "v"(hi)); return r; }
__device__ __forceinline__ bf16_t f2bf(float f) { return (bf16_t)(cvt_pk_bf16(f, 0.f) & 0xffffu); }
__device__ __forceinline__ float silu_f(float x) { return x * __builtin_amdgcn_rcpf(1.0f + __expf(-x)); }
__device__ __forceinline__ float wave_sum(float v) {
#pragma unroll
    for (int o = 1; o < 64; o <<= 1) v += __shfl_xor(v, o);
    return v;
}

namespace pg8 {
constexpr int BM = 256, BK = 64, HALF = 128, HTB = HALF * BK * 2  , STAGE_BYTES = 8 * HTB, NXCD = 8, WGM = 8;
__host__ __device__ __forceinline__ int lds_byte(int r, int c) { const int st = (r >> 4) * 2 + (c >> 5), rr = r & 15, cc = c & 31, ob = rr * 64 + cc * 2; return st * 1024 + (ob ^ (((ob >> 9) & 1) << 5)); }
__host__ __device__ __forceinline__ void stage_rc(int b, int& R, int& C) { const int st = b / 1024, sb = b % 1024, swz = sb ^ (((sb >> 9) & 1) << 5); R = (st >> 1) * 16 + swz / 64; C = (st & 1) * 32 + (swz % 64) / 2; }
__host__ __device__ __forceinline__ int perm32(int rho) { const int n = rho >> 4, i = rho & 15; return 8 * (i >> 2) + 4 * n + (i & 3); }

struct Unit { int pm, pn; };
struct Gemm { const bf16_t* A; const bf16_t* Bt; int lda, ldb, K; };

struct Order {
    int nM, nN, nwg, G, c, skipM, skipN, grp, ks, nNr, mmul, kbytes;
    __device__ __forceinline__ void init(int nM_, int nN_, int G_, int c_, int skipM_, int skipN_, int grp_) { nM = nM_; nN = nN_; nwg = nM * nN; G = G_; c = c_; skipM = skipM_; skipN = skipN_; grp = grp_; ks = 1; nNr = nN_; mmul = 1; kbytes = 0; }
    __device__ __forceinline__ void init_splitk(int nM_, int nNr_, int ks_, int kslice, int mmul_, int G_, int c_) { init(nM_, nNr_ * ks_, G_, c_, 0, 0, 0); ks = ks_; nNr = nNr_; mmul = mmul_; kbytes = kslice * 2; }
    __device__ __forceinline__ size_t a_byte(const Unit& u, size_t tstepA) const { return (size_t)(u.pm * mmul) * tstepA + a_off(u) + (ks > 1 ? (size_t)(u.pn / nNr) * (size_t)kbytes : 0u); }
    __device__ __forceinline__ size_t b_byte(const Unit& u, size_t tstepB) const { return ks > 1 ? (size_t)(u.pn % nNr) * tstepB + (size_t)(u.pn / nNr) * (size_t)kbytes : (size_t)u.pn * tstepB; }
    __device__ __forceinline__ bool next(int i, Unit& u) const {
        const long L = (long)i * G + c; if (L >= nwg) return false;
        int wgid = (int)L; { const int q = nwg / NXCD, r = nwg % NXCD, xcd = wgid % NXCD, off = wgid / NXCD; wgid = (xcd < r ? xcd * (q + 1) : r * (q + 1) + (xcd - r) * q) + off; }
        const int nig = WGM * nN, gid = wgid / nig, fm = gid * WGM, gsz = (nM - fm) < WGM ? (nM - fm) : WGM;
        u.pm = fm + ((wgid % nig) % gsz); u.pn = (wgid % nig) / gsz;
        if (skipM && u.pm >= 64) u.pm += 1;
        if (skipN && u.pn >= 64) u.pn += 1;
        return true;
    }
    __device__ __forceinline__ size_t a_off(const Unit& u) const { return grp ? (size_t)(u.pn >> 1) * 1024u : 0u; }
};

struct EpiPlain {
    static constexpr bool PERM = true;
    bf16_t* O; int ldc; const float* bias; const float* scale;
    __device__ __forceinline__ void operator()(const f32x4 (&acc)[2][2][4][2], const Unit& u, int wr, int wc, int fr, int fq) const {
        const int row0 = u.pm * BM + wr * 64 + fr, col0 = u.pn * BM + wc * 32 + 8 * fq;
        f32x4 bv[2][2], sv[2][2];
#pragma unroll
        for (int bj = 0; bj < 2; ++bj)
#pragma unroll
            for (int n = 0; n < 2; ++n) { bv[bj][n] = bias ? *(const f32x4*)(bias + col0 + bj * HALF + 4 * n) : (f32x4){0.f, 0.f, 0.f, 0.f};
                                          sv[bj][n] = scale ? *(const f32x4*)(scale + col0 + bj * HALF + 4 * n) : (f32x4){1.f, 1.f, 1.f, 1.f}; }
#pragma unroll
        for (int ai = 0; ai < 2; ++ai)
#pragma unroll
            for (int m = 0; m < 4; ++m) { bf16_t* rowp = O + (size_t)(row0 + ai * HALF + m * 16) * ldc + col0;
#pragma unroll
                for (int bj = 0; bj < 2; ++bj) { const f32x4 v0 = (acc[ai][bj][m][0] + bv[bj][0]) * sv[bj][0], v1 = (acc[ai][bj][m][1] + bv[bj][1]) * sv[bj][1];
                    u32x4 w; w.x = cvt_pk_bf16(v0[0], v0[1]); w.y = cvt_pk_bf16(v0[2], v0[3]); w.z = cvt_pk_bf16(v1[0], v1[1]); w.w = cvt_pk_bf16(v1[2], v1[3]);
                    *(u32x4*)(rowp + bj * HALF) = w; } }
    }
};
struct EpiSwiglu {
    static constexpr bool PERM = true;
    bf16_t* O; int ldc;
    static __device__ __forceinline__ float sw(float g, float u) { return (g * u) * __builtin_amdgcn_rcpf(1.0f + __builtin_amdgcn_exp2f(g)); }
    __device__ __forceinline__ void operator()(const f32x4 (&acc)[2][2][4][2], const Unit& u, int wr, int wc, int fr, int fq) const {
        const int row0 = u.pm * BM + wr * 64 + fr, col0 = u.pn * HALF + wc * 32 + 8 * fq;
#pragma unroll
        for (int ai = 0; ai < 2; ++ai)
#pragma unroll
            for (int m = 0; m < 4; ++m) { bf16_t* rowp = O + (size_t)(row0 + ai * HALF + m * 16) * ldc + col0;
                const f32x4 g0 = acc[ai][0][m][0], g1 = acc[ai][0][m][1], u0 = acc[ai][1][m][0], u1 = acc[ai][1][m][1];
                u32x4 w;
                w.x = cvt_pk_bf16(sw(g0[0], u0[0]), sw(g0[1], u0[1])); w.y = cvt_pk_bf16(sw(g0[2], u0[2]), sw(g0[3], u0[3]));
                w.z = cvt_pk_bf16(sw(g1[0], u1[0]), sw(g1[1], u1[1])); w.w = cvt_pk_bf16(sw(g1[2], u1[2]), sw(g1[3], u1[3]));
                *(u32x4*)rowp = w; }
    }
};
struct EpiQRope {
    static constexpr bool PERM = false;
    bf16_t* O; int ldc; const float* rope; float qscale;
    __device__ __forceinline__ void operator()(const f32x4 (&acc)[2][2][4][2], const Unit& u, int wr, int wc, int fr, int fq) const {
        const int row0 = u.pm * BM + wr * 64 + fr, col0 = u.pn * BM + wc * 32 + 4 * fq;
#pragma unroll
        for (int ai = 0; ai < 2; ++ai)
#pragma unroll
            for (int m = 0; m < 4; ++m) { const int row = row0 + ai * HALF + m * 16; const int t = row % TB; const int prow = (t >> 6) & 255, pcol = t & 63;
                bf16_t* rowp = O + (size_t)row * ldc + col0;
#pragma unroll
                for (int bj = 0; bj < 2; ++bj) { const int G = 8 * u.pn + 4 * bj + wc, gm = G % 6;
                    f32x4 x0 = acc[ai][bj][m][0], x1 = acc[ai][bj][m][1];
                    if (gm >= 4) { const int pos = (gm == 4) ? prow : pcol; const float* cs = rope + (size_t)(pos * 16 + 4 * fq) * 2;
                        const f32x4 c01 = *(const f32x4*)cs, c23 = *(const f32x4*)(cs + 4);
                        f32x4 o0, o1;
                        o0[0] = x0[0] * c01[0] - x1[0] * c01[1]; o1[0] = x1[0] * c01[0] + x0[0] * c01[1];
                        o0[1] = x0[1] * c01[2] - x1[1] * c01[3]; o1[1] = x1[1] * c01[2] + x0[1] * c01[3];
                        o0[2] = x0[2] * c23[0] - x1[2] * c23[1]; o1[2] = x1[2] * c23[0] + x0[2] * c23[1];
                        o0[3] = x0[3] * c23[2] - x1[3] * c23[3]; o1[3] = x1[3] * c23[2] + x0[3] * c23[3];
                        x0 = o0; x1 = o1; }
                    x0 *= qscale; x1 *= qscale;
                    u32x2 w0, w1; w0.x = cvt_pk_bf16(x0[0], x0[1]); w0.y = cvt_pk_bf16(x0[2], x0[3]); w1.x = cvt_pk_bf16(x1[0], x1[1]); w1.y = cvt_pk_bf16(x1[2], x1[3]);
                    *(u32x2*)(rowp + bj * HALF) = w0; *(u32x2*)(rowp + bj * HALF + 16) = w1; } }
    }
};

template <class Epi, bool ALIGN_EPI = true>
__device__ __forceinline__ void gemm_phase(LAS unsigned char* lds, const Gemm g, const Order& S, const Epi& E) {
    const int tid = threadIdx.x, wid = __builtin_amdgcn_readfirstlane(tid >> 6), lane = tid & 63, wr = wid >> 2, wc = wid & 3, fr = lane & 15, fq = lane >> 4;
    const int K = g.K, nt = K / BK;
    unsigned voffA[2], voffB[2];
#pragma unroll
    for (int i = 0; i < 2; ++i) { int R, C; stage_rc(tid * 16 + i * 8192, R, C); const int Rb = Epi::PERM ? ((R & ~31) + perm32(R & 31)) : R;
        voffA[i] = (unsigned)(R * g.lda + C) * 2u; voffB[i] = (unsigned)(Rb * g.ldb + C) * 2u; }
    const size_t kstep = (size_t)(BK * 2);
    const size_t hstepA = (size_t)HALF * g.lda * 2, hstepB = (size_t)HALF * g.ldb * 2;
    const size_t tstepA = 2 * hstepA, tstepB = 2 * hstepB;
    const unsigned ldsw = (unsigned)wid * 1024u;
    const int aoff = lds_byte(wr * 64 + fr, fq * 8), boff = lds_byte(wc * 32 + fr, fq * 8);
#define PG8_SA(b, h) (((b) * 2 + (h)) * HTB)
#define PG8_SB(b, h) ((4 + (b) * 2 + (h)) * HTB)
#define PG8_STAGE(bufoff, gbase, voff) do { _Pragma("unroll") for (int _i = 0; _i < 2; ++_i) \
        __builtin_amdgcn_global_load_lds((const unsigned*)((const char*)(gbase) + (voff)[_i]), (LAS unsigned*)(lds + (bufoff) + ldsw + _i * 8192), 16, 0, 0); } while (0)
#define PG8_LDA(dst, b, h) do { _Pragma("unroll") for (int m = 0; m < 4; ++m) _Pragma("unroll") for (int k = 0; k < 2; ++k) dst[m][k] = *(const LAS bf16x8*)(lds + PG8_SA(b, h) + aoff + m * 2048 + k * 1024); } while (0)
#define PG8_LDB(dst, b, h) do { _Pragma("unroll") for (int n = 0; n < 2; ++n) _Pragma("unroll") for (int k = 0; k < 2; ++k) dst[n][k] = *(const LAS bf16x8*)(lds + PG8_SB(b, h) + boff + n * 2048 + k * 1024); } while (0)
#define PG8_MMA(ai, bj, At, Bt) do { __builtin_amdgcn_s_setprio(1); _Pragma("unroll") for (int m = 0; m < 4; ++m) _Pragma("unroll") for (int n = 0; n < 2; ++n) _Pragma("unroll") for (int k = 0; k < 2; ++k) \
        acc[ai][bj][m][n] = __builtin_amdgcn_mfma_f32_16x16x32_bf16(Bt[n][k], At[m][k], acc[ai][bj][m][n], 0, 0, 0); __builtin_amdgcn_s_setprio(0); } while (0)
#define PG8_WAIT_V(n) asm volatile("s_waitcnt vmcnt(" #n ")" ::: "memory")
#define PG8_WAIT_L(n) asm volatile("s_waitcnt lgkmcnt(" #n ")" ::: "memory")
#define PG8_BAR __builtin_amdgcn_s_barrier()
#define PG8_SCHED __builtin_amdgcn_sched_barrier(0)
    Unit cur, nxt; int ui = 0;
    if (!S.next(0, cur)) return;
    f32x4 acc[2][2][4][2];
#pragma unroll
    for (int a = 0; a < 2; ++a)
#pragma unroll
        for (int b = 0; b < 2; ++b)
#pragma unroll
            for (int m = 0; m < 4; ++m)
#pragma unroll
                for (int n = 0; n < 2; ++n) acc[a][b][m][n] = (f32x4){0.f, 0.f, 0.f, 0.f};
    bf16x8 At[4][2], B0[2][2], B1[2][2];
    const char* cA = (const char*)g.A + S.a_byte(cur, tstepA); const char* cB = (const char*)g.Bt + S.b_byte(cur, tstepB);
    PG8_STAGE(PG8_SB(0, 0), cB, voffB); PG8_STAGE(PG8_SB(0, 1), cB + hstepB, voffB); PG8_STAGE(PG8_SA(0, 0), cA, voffA); PG8_STAGE(PG8_SA(0, 1), cA + hstepA, voffA);
    if (wr == 1) PG8_BAR;
    PG8_WAIT_V(2); PG8_BAR;
    PG8_STAGE(PG8_SB(1, 0), cB + kstep, voffB); PG8_STAGE(PG8_SA(1, 0), cA + kstep, voffA); PG8_STAGE(PG8_SB(1, 1), cB + hstepB + kstep, voffB);
    PG8_WAIT_V(6); PG8_BAR;
    for (;;) {
        const bool has_next = S.next(ui + 1, nxt);
        const char* nA = has_next ? (const char*)g.A + S.a_byte(nxt, tstepA) : cA; const char* nB = has_next ? (const char*)g.Bt + S.b_byte(nxt, tstepB) : cB;
        for (int t = 0; t < nt; t += 2) {
            const bool last = (t == nt - 2);
            const char* a1 = cA + (size_t)(t + 1) * kstep;
            const char* a2 = last ? nA : cA + (size_t)(t + 2) * kstep; const char* b2 = last ? nB : cB + (size_t)(t + 2) * kstep;
            const char* a3 = a2 + kstep; const char* b3 = b2 + kstep;
            PG8_LDB(B0, 0, 0); PG8_LDB(B1, 0, 1); PG8_SCHED; PG8_LDA(At, 0, 0); PG8_STAGE(PG8_SA(1, 1), a1 + hstepA, voffA);
            PG8_WAIT_V(8); PG8_WAIT_L(0); PG8_BAR; PG8_MMA(0, 0, At, B0); PG8_MMA(0, 1, At, B1); PG8_BAR; PG8_SCHED;
            PG8_LDA(At, 0, 1); PG8_STAGE(PG8_SB(0, 0), b2, voffB); PG8_STAGE(PG8_SB(0, 1), b2 + hstepB, voffB); PG8_STAGE(PG8_SA(0, 0), a2, voffA);
            PG8_WAIT_V(8); PG8_WAIT_L(0); PG8_BAR; PG8_MMA(1, 0, At, B0); PG8_MMA(1, 1, At, B1); PG8_BAR; PG8_SCHED;
            PG8_LDB(B0, 1, 0); PG8_LDB(B1, 1, 1); PG8_SCHED; PG8_LDA(At, 1, 0); PG8_STAGE(PG8_SA(0, 1), a2 + hstepA, voffA);
            PG8_WAIT_V(8); PG8_WAIT_L(0); PG8_BAR; PG8_MMA(0, 0, At, B0); PG8_MMA(0, 1, At, B1); PG8_BAR; PG8_SCHED;
            PG8_LDA(At, 1, 1); PG8_STAGE(PG8_SB(1, 0), b3, voffB); PG8_STAGE(PG8_SB(1, 1), b3 + hstepB, voffB); PG8_STAGE(PG8_SA(1, 0), a3, voffA);
            PG8_WAIT_V(8); PG8_WAIT_L(0); PG8_BAR; PG8_MMA(1, 0, At, B0); PG8_MMA(1, 1, At, B1); PG8_BAR; PG8_SCHED;
        }
        if constexpr (ALIGN_EPI) { if (wr == 0) PG8_BAR; }
        E(acc, cur, wr, wc, fr, fq);
        if (!has_next) break;
#pragma unroll
        for (int a = 0; a < 2; ++a)
#pragma unroll
            for (int b = 0; b < 2; ++b)
#pragma unroll
                for (int m = 0; m < 4; ++m)
#pragma unroll
                    for (int n = 0; n < 2; ++n) acc[a][b][m][n] = (f32x4){0.f, 0.f, 0.f, 0.f};
        cur = nxt; cA = nA; cB = nB; ++ui;
        if constexpr (ALIGN_EPI) { if (wr == 1) PG8_BAR; }
    }
    PG8_WAIT_V(0);
    if constexpr (!ALIGN_EPI) { if (wr == 0) PG8_BAR; }
    PG8_BAR;
#undef PG8_SA
#undef PG8_SB
#undef PG8_STAGE
#undef PG8_LDA
#undef PG8_LDB
#undef PG8_MMA
#undef PG8_WAIT_V
#undef PG8_WAIT_L
#undef PG8_BAR
#undef PG8_SCHED
}
}

#define XB_TMO      128
#define XB_XCNT(j)  (256  + 64 * (j))
#define XB_XSUB(j)  (1280 + 64 * (j))
#define XB_XGEN(j)  (2304 + 64 * (j))
#define XB_TOP      3328
#define XB_TOPGEN   3392
#define XCD_BAR_WORDS 3456
#define XB_SPIN_CAP (1u << 20)

__device__ __forceinline__ unsigned xb_ld(unsigned* p)              { return __hip_atomic_load(p, __ATOMIC_RELAXED, __HIP_MEMORY_SCOPE_AGENT); }
__device__ __forceinline__ unsigned xb_add(unsigned* p, unsigned v) { return __hip_atomic_fetch_add(p, v, __ATOMIC_RELAXED, __HIP_MEMORY_SCOPE_AGENT); }
__device__ __forceinline__ unsigned xb_xcc_id() { return (unsigned)__builtin_amdgcn_s_getreg((3 << 11) | 20) & 0xFu; }
#define XB_SPIN(cond, bar) do { unsigned _sp = 0; while (cond) { __builtin_amdgcn_s_sleep(1); \
    if ((++_sp & 255u) == 0u) { if (xb_ld(&(bar)[XB_TMO])) break; if (_sp > XB_SPIN_CAP) { atomicAdd(&(bar)[XB_TMO], 1u); break; } } } } while (0)

struct XcdBarrier {
    unsigned* bar; unsigned x;
    volatile LAS unsigned* st;
};
__device__ __forceinline__ XcdBarrier xcd_barrier_post(unsigned* bar, volatile LAS unsigned* st) {
    XcdBarrier b; b.bar = bar; b.x = xb_xcc_id(); b.st = st;
    if (threadIdx.x == 0) (void)xb_add(&bar[XB_XCNT(b.x)], 1u);
    return b;
}
__device__ __forceinline__ void xcd_barrier_complete(unsigned* bar, unsigned x, unsigned& nloc, unsigned& nx) {
    const unsigned G = gridDim.x * gridDim.y * gridDim.z;
    unsigned sum, cnt, mine, sp = 0u;
    for (;;) {
        sum = 0u; cnt = 0u; mine = 0u;
#pragma unroll
        for (unsigned j = 0; j < 16; ++j) { const unsigned c = xb_ld(&bar[XB_XCNT(j)]); sum += c; cnt += (c > 0u) ? 1u : 0u; mine = (j == x) ? c : mine; }
        if (sum == G) break;
        __builtin_amdgcn_s_sleep(1);
        if ((++sp & 255u) == 0u) { if (xb_ld(&bar[XB_TMO])) break; if (sp > XB_SPIN_CAP) { atomicAdd(&bar[XB_TMO], 1u); break; } }
    }
    nloc = mine > 0u ? mine : 1u; nx = cnt > 0u ? cnt : 1u;
}
__device__ __forceinline__ void xcd_barrier(const XcdBarrier& b) {
    asm volatile("s_waitcnt vmcnt(0)" ::: "memory");
    __syncthreads();
    if (threadIdx.x == 0) {
        unsigned* bar = b.bar;
        __builtin_amdgcn_s_waitcnt(0);
        unsigned nloc = b.st[0], nx = b.st[1];
        if (nloc == 0u) { xcd_barrier_complete(bar, b.x, nloc, nx); b.st[0] = nloc; b.st[1] = nx; }
        const unsigned old = xb_add(&bar[XB_XSUB(b.x)], 1u);
        const unsigned gen = old / nloc;
        if (old + 1u == (gen + 1u) * nloc) {
            __builtin_amdgcn_fence(__ATOMIC_RELEASE, "agent");
            asm volatile("s_waitcnt vmcnt(0)" ::: "memory");
            const unsigned og = xb_add(&bar[XB_TOP], 1u);
            const unsigned tg = og / nx;
            if (og + 1u == (tg + 1u) * nx) xb_add(&bar[XB_TOPGEN], 1u);
            else XB_SPIN(xb_ld(&bar[XB_TOPGEN]) == tg, bar);
            __builtin_amdgcn_fence(__ATOMIC_ACQUIRE, "agent");
            xb_add(&bar[XB_XGEN(b.x)], 1u);
            asm volatile("s_waitcnt vmcnt(0)" ::: "memory");
        } else {
            XB_SPIN(xb_ld(&bar[XB_XGEN(b.x)]) == gen, bar);
            __builtin_amdgcn_fence(__ATOMIC_ACQUIRE, "agent");
            asm volatile("s_waitcnt vmcnt(0)" ::: "memory");
        }
    }
    __syncthreads();
}

namespace att16 {
constexpr int DQK = 192, DV = 128, NW = 8, KVBLK = 64;
constexpr float SCALE = 0.07216878364870322f, QSCALE = SCALE * 1.4426950408889634f  , THR2 = 8.f * 1.4426950408889634f  ;
constexpr int LDQ = 3072, LDKV = 4096, LDKR = 64, LDO = 2048;
constexpr int VSTR = 2080;
constexpr int SHM_V = 8 * VSTR, SHM_K = KVBLK * DQK * 2, SHM_WS = 2 * SHM_V + 2 * SHM_K, SHM_ATTN = SHM_WS + NW * 64 * 4;
using s16x4 = __attribute__((ext_vector_type(4))) short;
#define KSWZ(row, colB) ((row) * 384 + ((colB) ^ ((((row) >> 1) & 7) << 4)))
#define SBAR() __builtin_amdgcn_sched_barrier(0)
__device__ __forceinline__ unsigned cvtpk(float lo, float hi) { unsigned r; asm volatile("v_cvt_pk_bf16_f32 %0, %1, %2" : "=v"(r) : "v"(lo), "v"(hi)); return r; }
template <int OFF> __device__ __forceinline__ s16x4 tr_read(int vb) { s16x4 r; asm volatile("ds_read_b64_tr_b16 %0, %1 offset:%2" : "=&v"(r) : "v"(vb), "i"(OFF) : "memory"); return r; }
__device__ __forceinline__ float red4(float x, bool is_max) {
  { auto r16 = __builtin_amdgcn_permlane16_swap(__float_as_uint(x), __float_as_uint(x), false, false);
    const float a = __uint_as_float(r16[0]), b = __uint_as_float(r16[1]); x = is_max ? fmaxf(a, b) : a + b; }
  auto rr = __builtin_amdgcn_permlane32_swap(__float_as_uint(x), __float_as_uint(x), false, false);
  const float a = __uint_as_float(rr[0]), b = __uint_as_float(rr[1]);
  return is_max ? fmaxf(a, b) : a + b;
}
struct VF { s16x4 a0, a1, b0, b1; };
template <int DB> __device__ __forceinline__ void v_rd(VF& f, int vb) { f.a0 = tr_read<DB * VSTR + 0>(vb); f.a1 = tr_read<DB * VSTR + 512>(vb); f.b0 = tr_read<DB * VSTR + 1024>(vb); f.b1 = tr_read<DB * VSTR + 1536>(vb); }
template <int DB> __device__ __forceinline__ void v_mm(f32x4 (&o)[2][8], const VF& f, const bf16x8 (&pa)[2][2]) {
  const bf16x8 v0 = (bf16x8){f.a0[0], f.a0[1], f.a0[2], f.a0[3], f.a1[0], f.a1[1], f.a1[2], f.a1[3]}, v1 = (bf16x8){f.b0[0], f.b0[1], f.b0[2], f.b0[3], f.b1[0], f.b1[1], f.b1[2], f.b1[3]};
  o[0][DB] = __builtin_amdgcn_mfma_f32_16x16x32_bf16(pa[0][0], v0, o[0][DB], 0, 0, 0);
  o[1][DB] = __builtin_amdgcn_mfma_f32_16x16x32_bf16(pa[1][0], v0, o[1][DB], 0, 0, 0);
  o[0][DB] = __builtin_amdgcn_mfma_f32_16x16x32_bf16(pa[0][1], v1, o[0][DB], 0, 0, 0);
  o[1][DB] = __builtin_amdgcn_mfma_f32_16x16x32_bf16(pa[1][1], v1, o[1][DB], 0, 0, 0);
}
__device__ __forceinline__ void pv_all(f32x4 (&o)[2][8], f32x4 (&ls)[2], int vb, const bf16x8 (&pa)[2][2]) {
  VF f0, f1, f2;
  asm volatile("s_waitcnt lgkmcnt(0)" ::: "memory");
  v_rd<0>(f0, vb); v_rd<1>(f1, vb);
#define W(N) asm volatile("s_waitcnt lgkmcnt(" #N ")" ::: "memory"); SBAR()
  v_rd<2>(f2, vb); W(8); v_mm<0>(o, f0, pa); SBAR();
  v_rd<3>(f0, vb); W(8); v_mm<1>(o, f1, pa); SBAR();
  v_rd<4>(f1, vb); W(8); v_mm<2>(o, f2, pa); SBAR();
  v_rd<5>(f2, vb); W(8); v_mm<3>(o, f0, pa); SBAR();
  v_rd<6>(f0, vb); W(8); v_mm<4>(o, f1, pa); SBAR();
  v_rd<7>(f1, vb); W(8); v_mm<5>(o, f2, pa); SBAR();
  W(4); v_mm<6>(o, f0, pa); SBAR();
  W(0); v_mm<7>(o, f1, pa);
#undef W
  const bf16x8 ones = {(short)0x3F80, (short)0x3F80, (short)0x3F80, (short)0x3F80, (short)0x3F80, (short)0x3F80, (short)0x3F80, (short)0x3F80};
  ls[0] = __builtin_amdgcn_mfma_f32_16x16x32_bf16(pa[0][0], ones, ls[0], 0, 0, 0); ls[1] = __builtin_amdgcn_mfma_f32_16x16x32_bf16(pa[1][0], ones, ls[1], 0, 0, 0);
  ls[0] = __builtin_amdgcn_mfma_f32_16x16x32_bf16(pa[0][1], ones, ls[0], 0, 0, 0); ls[1] = __builtin_amdgcn_mfma_f32_16x16x32_bf16(pa[1][1], ones, ls[1], 0, 0, 0);
}
__device__ __forceinline__ void attn_body(const bf16_t* __restrict__ Qb, const bf16_t* __restrict__ Kh, const bf16_t* __restrict__ Vh, const bf16_t* __restrict__ KRh,
                                          bf16_t* __restrict__ Ob, int seq, char* lds) {
  const int tid = threadIdx.x, wid = tid >> 6, lane = tid & 63, c15 = lane & 15, g = lane >> 4;
  char* V_lds = lds; char* K_lds = lds + 2 * SHM_V;
  float* ws = (float*)(lds + SHM_WS) + wid * 64; float* al_l = ws + 32;
  float m_reg[2] = {0.f, 0.f};
  f32x4 ls[2] = {(f32x4){0.f, 0.f, 0.f, 0.f}, (f32x4){0.f, 0.f, 0.f, 0.f}};
  f32x4 o[2][8];
#pragma unroll
  for (int qb = 0; qb < 2; ++qb)
#pragma unroll
    for (int db = 0; db < 8; ++db) o[qb][db] = (f32x4){0.f, 0.f, 0.f, 0.f};
  bf16x8 qf[2][6];
#pragma unroll
  for (int qb = 0; qb < 2; ++qb)
#pragma unroll
    for (int ks = 0; ks < 6; ++ks) qf[qb][ks] = *reinterpret_cast<const bf16x8*>(Qb + (long)(wid * 32 + 16 * qb + c15) * LDQ + 32 * ks + 8 * g);
  const int sr = tid >> 4, sc = (tid & 15) * 8, rr = tid >> 3, rc = (tid & 7) * 8;
  const int vst0 = (sc >> 4) * VSTR + (sr >> 2) * 128 + (sr & 3) * 32 + ((sc >> 3) & 1) * 16;
  const int ksw0 = KSWZ(sr, sc * 2), ksw2 = KSWZ(rr, 256 + rc * 2);
  int kbase[2];
#pragma unroll
  for (int e = 0; e < 2; ++e) kbase[e] = c15 * 384 + ((64 * e + 16 * g) ^ (((c15 >> 1) & 7) << 4));
  const int vb0 = (int)(uintptr_t)V_lds + g * 128 + c15 * 8;
  bf16x8 vs0, vs1, ks0, ks1, kr0;
  const unsigned kvoff = (unsigned)((sr * LDKV + sc) * 2), kvoff2 = kvoff + 32u * LDKV * 2u, kroff = (unsigned)((rr * LDKR + rc) * 2);
  const __amdgpu_buffer_rsrc_t rkv = __builtin_amdgcn_make_buffer_rsrc((void*)Kh, 0, 0x7fffffff, 0x00020000), rkr = __builtin_amdgcn_make_buffer_rsrc((void*)KRh, 0, 0x7fffffff, 0x00020000);
  (void)Vh;
#define BLD(R, VO, SO) __builtin_bit_cast(bf16x8, __builtin_amdgcn_raw_buffer_load_b128((R), (VO), (SO), 0))
#define SLOAD(k0) do { const unsigned so_ = (unsigned)(k0) * (unsigned)(LDKV * 2), sr_ = (unsigned)(k0) * (unsigned)(LDKR * 2); \
    vs0 = BLD(rkv, kvoff + 256u, so_); vs1 = BLD(rkv, kvoff2 + 256u, so_); ks0 = BLD(rkv, kvoff, so_); ks1 = BLD(rkv, kvoff2, so_); kr0 = BLD(rkr, kroff, sr_); } while (0)
#define SWRITE(b) do { *(bf16x8*)(V_lds + (b) * SHM_V + vst0) = vs0; *(bf16x8*)(V_lds + (b) * SHM_V + vst0 + 1024) = vs1; \
    *(bf16x8*)(K_lds + (b) * SHM_K + ksw0) = ks0; *(bf16x8*)(K_lds + (b) * SHM_K + ksw0 + 32 * 384) = ks1; *(bf16x8*)(K_lds + (b) * SHM_K + ksw2) = kr0; } while (0)
  const int NT = seq / KVBLK;
  SLOAD(0); asm volatile("s_waitcnt vmcnt(0)" ::: "memory"); SWRITE(0); __syncthreads();
#define KADDR(F, B) (K_lds + (B) * SHM_K + kbase[((F) % 6) & 1] + ((F) / 6) * (16 * 384) + (((F) % 6) >> 1) * 128)
#define KRD(FR, G, B) do { _Pragma("unroll") for (int i_ = 0; i_ < 4; ++i_) FR[i_] = *reinterpret_cast<const bf16x8*>(KADDR(4 * (G) + i_, B)); } while (0)
#define KMM(FR, G) do { _Pragma("unroll") for (int i_ = 0; i_ < 4; ++i_) { const int f_ = 4 * (G) + i_, kb_ = f_ / 6, ks_ = f_ % 6; \
        st[0][kb_] = __builtin_amdgcn_mfma_f32_16x16x32_bf16(FR[i_], qf[0][ks_], (ks_ == 0) ? ng4[0] : st[0][kb_], 0, 0, 0);   \
        st[1][kb_] = __builtin_amdgcn_mfma_f32_16x16x32_bf16(FR[i_], qf[1][ks_], (ks_ == 0) ? ng4[1] : st[1][kb_], 0, 0, 0); } } while (0)
#define TILE(B, NEXTK, HASNEXT, FIRST) do { \
    f32x4 st[2][4], ng4[2];   \
    _Pragma("unroll") for (int qb = 0; qb < 2; ++qb) { float ng = -m_reg[qb]; asm volatile("" : "+v"(ng)); ng4[qb] = (f32x4){ng, ng, ng, ng}; } \
    SBAR(); __builtin_amdgcn_s_setprio(1); \
    { bf16x8 fa[4], fb[4];   \
      KRD(fa, 0, B); SBAR(); \
      KRD(fb, 1, B); SBAR(); KMM(fa, 0); SBAR(); \
      KRD(fa, 2, B); SBAR(); KMM(fb, 1); SBAR(); \
      KRD(fb, 3, B); SBAR(); KMM(fa, 2); SBAR(); \
      KRD(fa, 4, B); SBAR(); KMM(fb, 3); SBAR(); \
      KRD(fb, 5, B); SBAR(); KMM(fa, 4); SBAR(); \
      KMM(fb, 5); } \
    __builtin_amdgcn_s_setprio(0); SBAR(); \
    if (HASNEXT) SLOAD(NEXTK); SBAR(); \
    { float pm[2]; \
      _Pragma("unroll") for (int qb = 0; qb < 2; ++qb) { float x = st[qb][0][0]; \
          _Pragma("unroll") for (int kb = 0; kb < 4; ++kb) _Pragma("unroll") for (int r = 0; r < 4; ++r) x = fmaxf(x, st[qb][kb][r]); \
          pm[qb] = red4(x, true); } \
      if ((FIRST) || !__builtin_expect(__all((pm[0] <= THR2) && (pm[1] <= THR2)), 1)) { \
          float al[2]; \
          _Pragma("unroll") for (int qb = 0; qb < 2; ++qb) { const float dl = (FIRST) ? pm[qb] : fmaxf(pm[qb], 0.f); m_reg[qb] += dl; al[qb] = __builtin_amdgcn_exp2f(-dl); \
              _Pragma("unroll") for (int kb = 0; kb < 4; ++kb) st[qb][kb] -= dl; } \
          if (!(FIRST)) { if (g == 0) { al_l[c15] = al[0]; al_l[16 + c15] = al[1]; } asm volatile("s_waitcnt lgkmcnt(0)" ::: "memory"); \
              _Pragma("unroll") for (int qb = 0; qb < 2; ++qb) { const f32x4 a4 = *(const f32x4*)(al_l + 16 * qb + 4 * g); ls[qb] *= a4; \
                  _Pragma("unroll") for (int db = 0; db < 8; ++db) o[qb][db] *= a4; } } } } \
    bf16x8 pa[2][2]; \
    _Pragma("unroll") for (int qb = 0; qb < 2; ++qb) { \
        _Pragma("unroll") for (int kb = 0; kb < 4; ++kb) _Pragma("unroll") for (int r = 0; r < 4; ++r) st[qb][kb][r] = __builtin_amdgcn_exp2f(st[qb][kb][r]); \
        _Pragma("unroll") for (int s2 = 0; s2 < 2; ++s2) { u32x4 w = {cvtpk(st[qb][2 * s2][0], st[qb][2 * s2][1]), cvtpk(st[qb][2 * s2][2], st[qb][2 * s2][3]), \
                                                                  cvtpk(st[qb][2 * s2 + 1][0], st[qb][2 * s2 + 1][1]), cvtpk(st[qb][2 * s2 + 1][2], st[qb][2 * s2 + 1][3])}; \
            pa[qb][s2] = *reinterpret_cast<bf16x8*>(&w); } } \
    SBAR(); __builtin_amdgcn_s_setprio(1); \
    { const int vb = vb0 + (B) * SHM_V; \
      pv_all(o, ls, vb, pa); } \
    __builtin_amdgcn_s_setprio(0); \
    if (HASNEXT) { asm volatile("s_waitcnt vmcnt(0)" ::: "memory"); SWRITE(1 - (B)); } \
    __syncthreads(); } while (0)
  TILE(0, KVBLK, true, true); TILE(1, 2 * KVBLK, true, false);
  for (int j = 2; j + 2 < NT; j += 2) { TILE(0, (j + 1) * KVBLK, true, false); TILE(1, (j + 2) * KVBLK, true, false); }
  TILE(0, (NT - 1) * KVBLK, true, false); TILE(1, 0, false, false);
#undef TILE
#undef KADDR
#undef KRD
#undef KMM
#undef SLOAD
#undef BLD
#undef SWRITE
#pragma unroll
  for (int qb = 0; qb < 2; ++qb) {
#pragma unroll
    for (int r = 0; r < 4; ++r) { const float rl = __builtin_amdgcn_rcpf(ls[qb][r]); bf16_t* orow = Ob + (long)(wid * 32 + 16 * qb + 4 * g + r) * LDO + c15;
#pragma unroll
      for (int db = 0; db < 8; ++db) orow[16 * db] = f2bf(o[qb][db][r] * rl); } }
}
#undef KSWZ
#undef SBAR
}

namespace fft {
constexpr int N = 16384, ROWP = 528, LDS_FFT_BYTES = 32 * ROWP * 8;
__device__ constexpr float C32[16] = {1.000000000e+00f, 9.807852804e-01f, 9.238795325e-01f, 8.314696123e-01f, 7.071067812e-01f, 5.555702330e-01f, 3.826834324e-01f, 1.950903220e-01f, 0.0f, -1.950903220e-01f, -3.826834324e-01f, -5.555702330e-01f, -7.071067812e-01f, -8.314696123e-01f, -9.238795325e-01f, -9.807852804e-01f};
__device__ constexpr float S32[16] = {0.000000000e+00f, 1.950903220e-01f, 3.826834324e-01f, 5.555702330e-01f, 7.071067812e-01f, 8.314696123e-01f, 9.238795325e-01f, 9.807852804e-01f, 1.000000000e+00f, 9.807852804e-01f, 9.238795325e-01f, 8.314696123e-01f, 7.071067812e-01f, 5.555702330e-01f, 3.826834324e-01f, 1.950903220e-01f};
__device__ constexpr float C64[32] = {1.000000000e+00f, 9.951847267e-01f, 9.807852804e-01f, 9.569403357e-01f, 9.238795325e-01f, 8.819212643e-01f, 8.314696123e-01f, 7.730104534e-01f, 7.071067812e-01f, 6.343932842e-01f, 5.555702330e-01f, 4.713967368e-01f, 3.826834324e-01f, 2.902846773e-01f, 1.950903220e-01f, 9.801714033e-02f, 0.0f, -9.801714033e-02f, -1.950903220e-01f, -2.902846773e-01f, -3.826834324e-01f, -4.713967368e-01f, -5.555702330e-01f, -6.343932842e-01f, -7.071067812e-01f, -7.730104534e-01f, -8.314696123e-01f, -8.819212643e-01f, -9.238795325e-01f, -9.569403357e-01f, -9.807852804e-01f, -9.951847267e-01f};
__device__ constexpr float S64[32] = {0.000000000e+00f, 9.801714033e-02f, 1.950903220e-01f, 2.902846773e-01f, 3.826834324e-01f, 4.713967368e-01f, 5.555702330e-01f, 6.343932842e-01f, 7.071067812e-01f, 7.730104534e-01f, 8.314696123e-01f, 8.819212643e-01f, 9.238795325e-01f, 9.569403357e-01f, 9.807852804e-01f, 9.951847267e-01f, 1.000000000e+00f, 9.951847267e-01f, 9.807852804e-01f, 9.569403357e-01f, 9.238795325e-01f, 8.819212643e-01f, 8.314696123e-01f, 7.730104534e-01f, 7.071067812e-01f, 6.343932842e-01f, 5.555702330e-01f, 4.713967368e-01f, 3.826834324e-01f, 2.902846773e-01f, 1.950903220e-01f, 9.801714033e-02f};
__host__ __device__ constexpr int brev(int k, int bits) { int r = 0; for (int i = 0; i < bits; ++i) r = (r << 1) | ((k >> i) & 1); return r; }

typedef f32x2 cf;
__device__ __forceinline__ cf cmul(cf a, cf w) { cf t, r;
    asm("v_pk_mul_f32 %0, %1, %2 op_sel_hi:[1,0]" : "=v"(t) : "v"(a), "v"(w));
    asm("v_pk_fma_f32 %0, %1, %2, %3 op_sel:[1,1,0] op_sel_hi:[0,1,1] neg_lo:[1,0,0]" : "=v"(r) : "v"(a), "v"(w), "v"(t));
    return r; }
__device__ __forceinline__ cf cmul_k(cf a, float c, float s) { const cf w = {c, s}; cf t, r;
    asm("v_pk_mul_f32 %0, %1, %2 op_sel_hi:[1,0]" : "=v"(t) : "v"(a), "s"(w));
    asm("v_pk_fma_f32 %0, %1, %2, %3 op_sel:[1,1,0] op_sel_hi:[0,1,1] neg_lo:[1,0,0]" : "=v"(r) : "v"(a), "s"(w), "v"(t));
    return r; }
template <bool INV> __device__ __forceinline__ cf sub_rot(cf a, cf c) { cf r;
    if constexpr (!INV) asm("v_pk_add_f32 %0, %1, %2 op_sel:[1,1] op_sel_hi:[0,0] neg_lo:[0,1] neg_hi:[1,0]" : "=v"(r) : "v"(a), "v"(c));
    else asm("v_pk_add_f32 %0, %1, %2 op_sel:[1,1] op_sel_hi:[0,0] neg_lo:[1,0] neg_hi:[0,1]" : "=v"(r) : "v"(a), "v"(c));
    return r; }
__device__ __forceinline__ cf cadd(cf a, cf c) { return a + c; }
__device__ __forceinline__ cf csub(cf a, cf c) { return a - c; }
template <int R, int LEN, bool INV, int OFF>
__device__ __forceinline__ void stage(cf (&x)[32]) {
    constexpr int half = LEN / 2, tws = 32 / LEN;
#pragma unroll
    for (int b = 0; b < R; b += LEN)
#pragma unroll
        for (int j = 0; j < half; ++j) {
            const int i0 = OFF + b + j, i1 = i0 + half;
            const cf a = x[i0], c = x[i1];
            x[i0] = cadd(a, c);
            const int e = j * tws;
            if (e == 0) x[i1] = csub(a, c);
            else if (e == 8) x[i1] = sub_rot<INV>(a, c);
            else x[i1] = cmul_k(csub(a, c), C32[e], INV ? S32[e] : -S32[e]);
        }
}
template <int R, bool INV, int OFF>
__device__ __forceinline__ void dft(cf (&x)[32]) {
    if constexpr (R >= 32) stage<R, 32, INV, OFF>(x);
    if constexpr (R >= 16) stage<R, 16, INV, OFF>(x);
    stage<R, 8, INV, OFF>(x); stage<R, 4, INV, OFF>(x); stage<R, 2, INV, OFF>(x);
}
struct Tw {
    float wAr, wAi;
    float wBr, wBi;
    float wCr, wCi;
    float wD0r, wD0i;
    float wDr, wDi;
    float wMr, wMi;
};
__device__ __forceinline__ void tw_init(Tw& t, int tid) {
    float s, c;
    sincospif(-2.0f * (float)tid / 16384.0f, &s, &c); t.wAr = c; t.wAi = s;
    sincospif(-2.0f * (float)(tid & 15) / 512.0f, &s, &c); t.wBr = c; t.wBi = s;
    sincospif(2.0f * (float)(tid & 31) / 512.0f, &s, &c); t.wCr = c; t.wCi = s;
    sincospif(2.0f * (float)((tid >> 4) * (tid & 15)) / 16384.0f, &s, &c); t.wD0r = c; t.wD0i = s;
    sincospif(2.0f * (float)(tid >> 4) / 1024.0f, &s, &c); t.wDr = c; t.wDi = s;
    sincospif(-(float)tid / 16384.0f, &s, &c); t.wMr = c; t.wMi = s;
}
#define FFT_SYNC() do { asm volatile("s_waitcnt lgkmcnt(0)" ::: "memory"); __builtin_amdgcn_s_barrier(); asm volatile("" ::: "memory"); } while (0)
__device__ __forceinline__ int opq(int x) { asm volatile("" : "+v"(x)); return x; }
__device__ __forceinline__ float opqf(float x) { asm volatile("" : "+v"(x)); return x; }
__device__ __forceinline__ void fwd(cf (&x)[32], LAS f32x2* X, const Tw& t, int tid_) {
    dft<32, false, 0>(x);
    { const int tid = opq(tid_); const cf w = {opqf(t.wAr), opqf(t.wAi)}; cf p = {1.f, 0.f}; const int rb = (tid & ~15), rs = tid & 15, key = (tid >> 5) & 15; const int col = rb + (rs ^ key);
#pragma unroll
      for (int k1 = 0; k1 < 32; ++k1) { X[k1 * ROWP + col] = cmul(x[brev(k1, 5)], p); p = cmul(p, w); } }
    FFT_SYNC();
    { const int tid = opq(tid_); const cf w = {opqf(t.wBr), opqf(t.wBi)}; const int k1 = tid >> 4, s = tid & 15; LAS f32x2* row = X + k1 * ROWP;
#pragma unroll
      for (int r1 = 0; r1 < 32; ++r1) x[r1] = row[r1 * 16 + (s ^ ((r1 >> 1) & 15))];
      dft<32, false, 0>(x);
      cf p = {1.f, 0.f};
#pragma unroll
      for (int k2 = 0; k2 < 32; ++k2) { row[k2 * 16 + (s ^ ((k2 >> 1) & 15))] = cmul(x[brev(k2, 5)], p); p = cmul(p, w); } }
    FFT_SYNC();
    { const int tid = opq(tid_); const int k2 = tid & 31, key = (k2 >> 1) & 15;
#pragma unroll
      for (int j = 0; j < 2; ++j) { const int k1 = (tid + 512 * j) >> 5; LAS f32x2* p = X + k1 * ROWP + k2 * 16;
#pragma unroll
          for (int s = 0; s < 16; ++s) x[16 * j + s] = p[s ^ key]; }
      dft<16, false, 0>(x); dft<16, false, 16>(x); }
    FFT_SYNC();
}
__device__ __forceinline__ void inv(cf (&x)[32], LAS f32x2* X, const Tw& t, int tid_) {
    { const int tid = opq(tid_); const cf w = {opqf(t.wCr), opqf(t.wCi)}; cf y[32];
#pragma unroll
      for (int j = 0; j < 2; ++j)
#pragma unroll
          for (int k3 = 0; k3 < 16; ++k3) y[16 * j + k3] = x[16 * j + brev(k3, 4)];
      dft<16, true, 0>(y); dft<16, true, 16>(y);
      const int k2 = tid & 31, key = (k2 >> 1) & 15;
#pragma unroll
      for (int j = 0; j < 2; ++j) { const int k1 = (tid + 512 * j) >> 5; LAS f32x2* p = X + k1 * ROWP + k2 * 16; cf q = {1.f, 0.f};
#pragma unroll
          for (int s = 0; s < 16; ++s) { p[s ^ key] = cmul(y[16 * j + brev(s, 4)], q); q = cmul(q, w); } } }
    FFT_SYNC();
    { const int tid = opq(tid_); const cf w = {opqf(t.wDr), opqf(t.wDi)}; const int k1 = tid >> 4, s = tid & 15; LAS f32x2* row = X + k1 * ROWP;
#pragma unroll
      for (int k2 = 0; k2 < 32; ++k2) x[k2] = row[k2 * 16 + (s ^ ((k2 >> 1) & 15))];
      dft<32, true, 0>(x);
      cf p = {opqf(t.wD0r), opqf(t.wD0i)};
#pragma unroll
      for (int r1 = 0; r1 < 32; ++r1) { row[r1 * 16 + (s ^ ((r1 >> 1) & 15))] = cmul(x[brev(r1, 5)], p); p = cmul(p, w); } }
    FFT_SYNC();
    { const int tid = opq(tid_); const int rb = (tid & ~15), rs = tid & 15, key = (tid >> 5) & 15; const int col = rb + (rs ^ key);
      cf y[32];
#pragma unroll
      for (int k1 = 0; k1 < 32; ++k1) y[k1] = X[k1 * ROWP + col];
      dft<32, true, 0>(y);
#pragma unroll
      for (int n1 = 0; n1 < 32; ++n1) x[n1] = y[brev(n1, 5)]; }
    FFT_SYNC();
}

__device__ __forceinline__ float conv3(const bf16_t* seg, int n, int len, float b, float w0, float w1, float w2, float cb) {
    const float vm = bf2f(seg[n > 0 ? n - 1 : 0]) + b, pc = bf2f(seg[n]) + b, vp = bf2f(seg[n + 1 < len ? n + 1 : len - 1]) + b;
    const float pm = (n > 0) ? vm : 0.f, pp = (n + 1 < len) ? vp : 0.f;
    return w0 * pm + w1 * pc + w2 * pp + cb;
}
__device__ __forceinline__ float conv3l(const LAS bf16_t* seg, int n, float b, float w0, float w1, float w2, float cb) {
    const float pm = (n > 0) ? bf2f(seg[n - 1]) + b : 0.f, pc = bf2f(seg[n]) + b, pp = (n + 1 < 16384) ? bf2f(seg[n + 1]) + b : 0.f;
    return w0 * pm + w1 * pc + w2 * pp + cb;
}
struct ConvCh {
    float b0, b1, bv, w00, w01, w02, c0, w10, w11, w12, c1, wv0, wv1, wv2, cv;
};
__device__ __forceinline__ void load_ch(ConvCh& p, const float* b_in, const float* conv_w, const float* conv_b, int d) {
    p.b0 = b_in[d]; p.b1 = b_in[D + d]; p.bv = b_in[2 * D + d];
    p.w00 = conv_w[d]; p.w01 = conv_w[3 * D + d]; p.w02 = conv_w[6 * D + d]; p.c0 = conv_b[d];
    p.w10 = conv_w[D + d]; p.w11 = conv_w[3 * D + D + d]; p.w12 = conv_w[6 * D + D + d]; p.c1 = conv_b[D + d];
    p.wv0 = conv_w[2 * D + d]; p.wv1 = conv_w[3 * D + 2 * D + d]; p.wv2 = conv_w[6 * D + 2 * D + d]; p.cv = conv_b[2 * D + d];
}

__device__ __forceinline__ f32x2 unpk(unsigned w) { return (f32x2){__uint_as_float(w << 16), __uint_as_float(w & 0xffff0000u)}; }
__device__ __forceinline__ void conv_channel(int d, const bf16_t* projT, const float* filtT, const float* b_in, const float* conv_w, const float* conv_b, const float* hy_bias,
                                             bf16_t* yT, unsigned* scr, LAS unsigned char* lds, const Tw& tw, int tid, float (&hn)[32], int dnext) {
    LAS f32x2* X = (LAS f32x2*)lds; LAS float* red = (LAS float*)(lds + LDS_FFT_BYTES); const int tid_ = tid;
    unsigned* He = scr; unsigned* Ho = scr + 32 * 512;
    cf x[32]; unsigned pk[32];
    float scale; const float bias = hy_bias[d];
    { float s = 0.f; const int tq1 = opq(tid_);
#pragma unroll
      for (int n1 = 0; n1 < 32; ++n1) s += fabsf(hn[n1]);
      s = wave_sum(s); if ((tid & 63) == 0) red[tid >> 6] = s; __syncthreads();
      float tot = 0.f;
#pragma unroll
      for (int w = 0; w < 8; ++w) tot += red[w];
      scale = 1.0f / tot;
#pragma unroll
      for (int n1 = 0; n1 < 32; ++n1) { hn[n1] *= scale; if (n1 == 16 && tq1 == 0) hn[n1] += bias; x[n1] = (cf){hn[n1], 0.f}; } }
    fwd(x, X, tw, tid);
    { const int tq3 = opq(tid_);
#pragma unroll
    for (int i = 0; i < 32; ++i) He[i * 512 + tq3] = cvt_pk_bf16(x[i].x, x[i].y);
    }
#pragma unroll
    for (int n1 = 0; n1 < 32; ++n1) { const float wMr = opqf(tw.wMr), wMi = opqf(tw.wMi); const float mr = wMr * C64[n1] + wMi * S64[n1], mi = wMi * C64[n1] - wMr * S64[n1];
        x[n1] = (cf){hn[n1] * mr, hn[n1] * mi}; }
    const bf16_t* r0 = projT + (size_t)d * TM; const bf16_t* r1 = projT + (size_t)(D + d) * TM; const bf16_t* rv = projT + (size_t)(2 * D + d) * TM;
    u32x4 st[16];
    { const int tq6 = opq(tid_);
#pragma unroll
      for (int i = 0; i < 4; ++i) { const int c = (tq6 + 512 * i) * 8;
          st[i] = *(const u32x4*)(rv + c); st[4 + i] = *(const u32x4*)(r1 + c); st[8 + i] = *(const u32x4*)(rv + TB + c); st[12 + i] = *(const u32x4*)(r1 + TB + c); } }
    fwd(x, X, tw, tid);
    { const int tq5 = opq(tid_);
#pragma unroll
    for (int i = 0; i < 32; ++i) Ho[i * 512 + tq5] = cvt_pk_bf16(x[i].x, x[i].y);
    }
    { const int tq6 = opq(tid_);
#pragma unroll
      for (int q = 0; q < 4; ++q)
#pragma unroll
          for (int i = 0; i < 4; ++i) *(LAS u32x4*)(lds + q * 32768 + (tq6 + 512 * i) * 16) = st[4 * q + i]; }
    __syncthreads();
    { ConvCh p; load_ch(p, b_in, conv_w, conv_b, d); const int tq6 = opq(tid_);
      const LAS bf16_t* lv0 = (const LAS bf16_t*)lds; const LAS bf16_t* l10 = lv0 + 16384; const LAS bf16_t* lv1 = lv0 + 32768; const LAS bf16_t* l11 = lv0 + 49152;
#pragma unroll
      for (int n1 = 0; n1 < 32; ++n1) { const int n = 512 * n1 + tq6;
        x[n1].x = conv3l(lv0, n, p.bv, p.wv0, p.wv1, p.wv2, p.cv) * conv3l(l10, n, p.b1, p.w10, p.w11, p.w12, p.c1);
        x[n1].y = conv3l(lv1, n, p.bv, p.wv0, p.wv1, p.wv2, p.cv) * conv3l(l11, n, p.b1, p.w10, p.w11, p.w12, p.c1);
        pk[n1] = cvt_pk_bf16(x[n1].x, x[n1].y); } }
    __syncthreads();
    { unsigned hk[32]; { const int tq7 = opq(tid_);
#pragma unroll
      for (int i = 0; i < 32; ++i) hk[i] = He[i * 512 + tq7]; }
      fwd(x, X, tw, tid);
#pragma unroll
      for (int i = 0; i < 32; ++i) x[i] = cmul(x[i], unpk(hk[i])); }
    inv(x, X, tw, tid);
#pragma unroll
    for (int n1 = 0; n1 < 32; ++n1) { const float wMr = opqf(tw.wMr), wMi = opqf(tw.wMi); const float mr = wMr * C64[n1] + wMi * S64[n1], mi = wMi * C64[n1] - wMr * S64[n1];
        const unsigned z = pk[n1]; pk[n1] = cvt_pk_bf16(x[n1].x, x[n1].y); x[n1] = cmul(unpk(z), (cf){mr, mi}); }
    { unsigned hk[32]; { const int tq10 = opq(tid_);
#pragma unroll
      for (int i = 0; i < 32; ++i) hk[i] = Ho[i * 512 + tq10]; }
      fwd(x, X, tw, tid);
#pragma unroll
      for (int i = 0; i < 32; ++i) x[i] = cmul(x[i], unpk(hk[i])); }
    u32x4 st0[8];
    { const int tq12 = opq(tid_);
#pragma unroll
      for (int i = 0; i < 4; ++i) { const int c = (tq12 + 512 * i) * 8; st0[i] = *(const u32x4*)(r0 + c); st0[4 + i] = *(const u32x4*)(r0 + TB + c); } }
    inv(x, X, tw, tid);
    bf16_t* o0 = yT + (size_t)d * TM; bf16_t* o1 = o0 + TB;
    { const int tq12 = opq(tid_);
#pragma unroll
      for (int q = 0; q < 2; ++q)
#pragma unroll
          for (int i = 0; i < 4; ++i) *(LAS u32x4*)(lds + q * 32768 + (tq12 + 512 * i) * 16) = st0[4 * q + i]; }
    if (dnext < D) { const float* hnx = filtT + (size_t)dnext * N; const int tq13 = opq(tid_);
#pragma unroll
      for (int n1 = 0; n1 < 32; ++n1) hn[n1] = hnx[512 * n1 + tq13]; }
    __syncthreads();
    const float pb0 = b_in[d], pw0 = conv_w[d], pw1 = conv_w[3 * D + d], pw2 = conv_w[6 * D + d], pc0 = conv_b[d];
    { const int tq11 = opq(tid_);
      const LAS bf16_t* l00 = (const LAS bf16_t*)lds; const LAS bf16_t* l01 = l00 + 16384;
#pragma unroll
    for (int n1 = 0; n1 < 32; ++n1) { const int m = 512 * n1 + tq11;
        const float wMr = opqf(tw.wMr), wMi = opqf(tw.wMi); const float mr = wMr * C64[n1] + wMi * S64[n1], mi = wMi * C64[n1] - wMr * S64[n1];
        const float qr = x[n1].x * mr + x[n1].y * mi, qi = x[n1].y * mr - x[n1].x * mi;
        const f32x2 e = unpk(pk[n1]);
        const float sg = (n1 >= 16) ? 1.f : -1.f; const int t = (n1 >= 16) ? m - 8192 : m + 8192;
        const float y0 = (e.x + sg * qr) * (0.5f / 16384.0f), y1 = (e.y + sg * qi) * (0.5f / 16384.0f);
        const float g0 = conv3l(l00, t, pb0, pw0, pw1, pw2, pc0), g1 = conv3l(l01, t, pb0, pw0, pw1, pw2, pc0);
        o0[t] = f2bf(g0 * y0); o1[t] = f2bf(g1 * y1); }
    }
    __syncthreads();
}

__device__ __forceinline__ void conv_ctx_channel(int d, const bf16_t* projT, const float* filtC, const float* b_in, const float* conv_w, const float* conv_b, const float* hy_bias,
                                                 bf16_t* yT, LAS float* wl, int lane) {
    ConvCh p; load_ch(p, b_in, conv_w, conv_b, d);
    const bf16_t* r0 = projT + (size_t)d * TM + SEQ; const bf16_t* r1 = projT + (size_t)(D + d) * TM + SEQ; const bf16_t* rv = projT + (size_t)(2 * D + d) * TM + SEQ;
    LAS float* hl = wl; LAS float* z0 = wl + 256; LAS float* z1 = wl + 512;
    float hv[4]; float s = 0.f;
#pragma unroll
    for (int i = 0; i < 4; ++i) { hv[i] = filtC[(size_t)d * CTXL + 64 * i + lane]; s += fabsf(hv[i]); }
    s = wave_sum(s); const float scale = 1.0f / s; const float bias = hy_bias[d];
#pragma unroll
    for (int i = 0; i < 4; ++i) { const int n = 64 * i + lane; float h = hv[i] * scale; if (n == CTXL / 2) h += bias; hl[n] = h;
        z0[n] = conv3(rv, n, CTXL, p.bv, p.wv0, p.wv1, p.wv2, p.cv) * conv3(r1, n, CTXL, p.b1, p.w10, p.w11, p.w12, p.c1);
        z1[n] = conv3(rv + TB, n, CTXL, p.bv, p.wv0, p.wv1, p.wv2, p.cv) * conv3(r1 + TB, n, CTXL, p.b1, p.w10, p.w11, p.w12, p.c1); }
    asm volatile("s_waitcnt lgkmcnt(0)" ::: "memory");
    float a0[4] = {0.f, 0.f, 0.f, 0.f}, a1[4] = {0.f, 0.f, 0.f, 0.f};
    for (int j = 0; j < CTXL; ++j) { const float h = hl[j];
#pragma unroll
        for (int i = 0; i < 4; ++i) { const int q = 64 * i + lane + CTXL / 2 - j; const bool ok = (q >= 0) && (q < CTXL); const int qq = ok ? q : 0;
            const float v0 = z0[qq], v1 = z1[qq]; a0[i] += ok ? h * v0 : 0.f; a1[i] += ok ? h * v1 : 0.f; } }
    bf16_t* o0 = yT + (size_t)d * TM + SEQ; bf16_t* o1 = o0 + TB;
#pragma unroll
    for (int i = 0; i < 4; ++i) { const int t = 64 * i + lane;
        o0[t] = f2bf(conv3(r0, t, CTXL, p.b0, p.w00, p.w01, p.w02, p.c0) * a0[i]); o1[t] = f2bf(conv3(r0 + TB, t, CTXL, p.b0, p.w00, p.w01, p.w02, p.c0) * a1[i]); }
    asm volatile("s_waitcnt lgkmcnt(0)" ::: "memory");
}
}

struct CvtJob { const float* src; bf16_t* dst; int K, N, mode, start; };
constexpr int NJOBS = 24;
__device__ __forceinline__ unsigned f2bf_sw(float f) { unsigned u = __builtin_bit_cast(unsigned, f); return (u + 0x7fffu + ((u >> 16) & 1u)) >> 16; }
__device__ __forceinline__ unsigned pk2(float lo, float hi) { return f2bf_sw(lo) | (f2bf_sw(hi) << 16); }
struct CvtItem { const float* src; bf16_t* dst; int N, K; float sc; };
__device__ __forceinline__ void cvt_locate(const CvtJob& jb, int item, CvtItem& t) {
    const int nblk = jb.N / 64, kb = item / nblk, nb = item % nblk, k0 = 64 * kb, n0 = 64 * nb;
    const int rbase = (jb.mode == 0) ? n0 : ((n0 >> 7) * 256 + (n0 & 127) + (jb.mode == 2 ? 128 : 0));
    t.src = jb.src + (size_t)k0 * jb.N + n0; t.dst = jb.dst + (size_t)rbase * jb.K + k0; t.N = jb.N; t.K = jb.K; t.sc = (jb.mode == 1) ? -1.4426950408889634f : ((jb.mode == 2) ? -0.6931471805599453f : 1.0f);
}
__device__ __forceinline__ void cvt_load(const CvtItem& t, f32x4 (&v)[16], int lane) {
    const int c4 = lane & 15, kr = lane >> 4;
#pragma unroll
    for (int i = 0; i < 16; ++i) { const int k = 2 * (kr + 4 * (i >> 1)) + (i & 1); v[i] = *(const f32x4*)(t.src + (size_t)k * t.N + 4 * c4); }
}
__device__ __forceinline__ void cvt_store(const CvtItem& t, const f32x4 (&v)[16], LAS unsigned* scr, int lane) {
    const int c4 = lane & 15, kr = lane >> 4;
#pragma unroll
    for (int j = 0; j < 8; ++j)
#pragma unroll
        for (int c = 0; c < 4; ++c) scr[(4 * c4 + c) * 33 + kr + 4 * j] = cvt_pk_bf16(v[2 * j][c] * t.sc, v[2 * j + 1][c] * t.sc);
    asm volatile("s_waitcnt lgkmcnt(0)" ::: "memory");
    const int q = lane & 7;
#pragma unroll
    for (int i = 0; i < 8; ++i) { const int n = (lane >> 3) + 8 * i; const LAS unsigned* s = scr + n * 33 + 4 * q;
        u32x4 o; o.x = s[0]; o.y = s[1]; o.z = s[2]; o.w = s[3];
        *(u32x4*)(t.dst + (size_t)n * t.K + 8 * q) = o; }
    asm volatile("s_waitcnt lgkmcnt(0)" ::: "memory");
}

__device__ __forceinline__ void adaln_job(int job, const float* c, const float* c_ctx, const float* ada_w, const float* ada_b, float* mod, LAS unsigned char* lds, int tid) {
    LAS float* sv = (LAS float*)lds;
    LAS float* red = (LAS float*)(lds + 24576);
    const int layer = job >> 6, colbase = (job & 63) * 192;
    for (int i = tid; i < 3 * D; i += 512) { const int r = i / D, k = i % D; const float v = (r < 2) ? c[r * D + k] : c_ctx[k]; sv[i] = v / (1.0f + expf(-v)); }
    __syncthreads();
    const int cq = tid & 15, kg = tid >> 4;
    f32x4 a[3][3];
#pragma unroll
    for (int p = 0; p < 3; ++p)
#pragma unroll
        for (int r = 0; r < 3; ++r) a[p][r] = (f32x4){0.f, 0.f, 0.f, 0.f};
    const float* wp = ada_w + ((size_t)layer * D + (size_t)kg * 64) * MODW + colbase + cq * 4;
#pragma unroll 8
    for (int kk = 0; kk < 64; ++kk) { const f32x4 w0 = *(const f32x4*)(wp + (size_t)kk * MODW), w1 = *(const f32x4*)(wp + (size_t)kk * MODW + 64), w2 = *(const f32x4*)(wp + (size_t)kk * MODW + 128);
        const int k = kg * 64 + kk; const float s0 = sv[k], s1 = sv[D + k], s2 = sv[2 * D + k];
        a[0][0] += w0 * s0; a[0][1] += w0 * s1; a[0][2] += w0 * s2;
        a[1][0] += w1 * s0; a[1][1] += w1 * s1; a[1][2] += w1 * s2;
        a[2][0] += w2 * s0; a[2][1] += w2 * s1; a[2][2] += w2 * s2; }
#pragma unroll
    for (int p = 0; p < 3; ++p)
#pragma unroll
        for (int r = 0; r < 3; ++r)
#pragma unroll
            for (int j = 0; j < 4; ++j) red[(kg * 3 + r) * 192 + p * 64 + cq * 4 + j] = a[p][r][j];
    __syncthreads();
    for (int o = tid; o < 3 * 192; o += 512) { const int r = o / 192, cc = o % 192; float s = 0.f;
        for (int g = 0; g < 32; ++g) s += red[(g * 3 + r) * 192 + cc];
        const int n = colbase + cc;
        mod[((size_t)layer * 3 + r) * MODW + n] = s + ada_b[(size_t)layer * MODW + n]; }
    __syncthreads();
}

__device__ __forceinline__ void filter_job(int job, int Lf, const float* f_w_in, const float* f_w_hid, const float* f_b, const float* f_freq, const float* f_w_out, float* filtT,
                                           LAS unsigned char* lds, int tid) {
    LAS float* zb = (LAS float*)lds;
    LAS float* ga = zb + 64 * 33;
    LAS float* gb = ga + 64 * 65;
    LAS float* wl = gb + 64 * 65;
    LAS float* w_in = wl; LAS float* w_h = wl + 33 * 64; LAS float* bb = w_h + 2 * 64 * 64; LAS float* fq = bb + 192;
    const int p0 = job * 64;
    for (int i = tid; i < 33 * 64; i += 512) w_in[i] = f_w_in[i];
    for (int i = tid; i < 2 * 64 * 64; i += 512) w_h[i] = f_w_hid[i];
    if (tid < 192) { bb[tid] = f_b[tid]; fq[tid] = f_freq[tid]; }
    for (int i = tid; i < 64 * 33; i += 512) { const int pl = i / 33, k = i % 33; const float pos = (float)(p0 + pl); float v;
        if (k == 0) v = pos / (float)(Lf - 1);
        else { const int b = (k - 1) & 15; const float band = 1e-4f + (float)b * ((15.0f - 1e-4f) / 15.0f); const float ang = ((float)(6.283185307179586 / (double)Lf) * pos) * band;
               v = (k <= 16) ? cosf(ang) : -sinf(ang); }
        zb[i] = v; }
    __syncthreads();
    const int pl = tid >> 3, f0 = (tid & 7) * 8;
    { float a[8];
#pragma unroll
      for (int j = 0; j < 8; ++j) a[j] = 0.f;
#pragma unroll 1
      for (int k = 0; k < 33; ++k) { const float zv = zb[pl * 33 + k];
#pragma unroll
          for (int j = 0; j < 8; ++j) a[j] += zv * w_in[k * 64 + f0 + j]; }
#pragma unroll
      for (int j = 0; j < 8; ++j) ga[pl * 65 + f0 + j] = sinf(fq[f0 + j] * (a[j] + bb[f0 + j])); }
    __syncthreads();
    { float a[8];
#pragma unroll
      for (int j = 0; j < 8; ++j) a[j] = 0.f;
#pragma unroll 2
      for (int k = 0; k < 64; ++k) { const float gv = ga[pl * 65 + k];
#pragma unroll
          for (int j = 0; j < 8; ++j) a[j] += gv * w_h[k * 64 + f0 + j]; }
#pragma unroll
      for (int j = 0; j < 8; ++j) gb[pl * 65 + f0 + j] = sinf(fq[64 + f0 + j] * (a[j] + bb[64 + f0 + j])); }
    __syncthreads();
    { float a[8];
#pragma unroll
      for (int j = 0; j < 8; ++j) a[j] = 0.f;
#pragma unroll 2
      for (int k = 0; k < 64; ++k) { const float gv = gb[pl * 65 + k];
#pragma unroll
          for (int j = 0; j < 8; ++j) a[j] += gv * w_h[64 * 64 + k * 64 + f0 + j]; }
#pragma unroll
      for (int j = 0; j < 8; ++j) ga[pl * 65 + f0 + j] = sinf(fq[128 + f0 + j] * (a[j] + bb[128 + f0 + j])); }
    __syncthreads();
    { typedef float f32x16 __attribute__((ext_vector_type(16)));
      const int lane = tid & 63, wv = __builtin_amdgcn_readfirstlane(tid >> 6), li = lane & 31, lh = lane >> 5;
      const float invh = 1.0f / (float)(Lf / 2);
#define SPLIT8(V, HI, LO) do { u32x4 h_, l_; _Pragma("unroll") for (int q_ = 0; q_ < 4; ++q_) { const unsigned hp_ = cvt_pk_bf16((V)[2 * q_], (V)[2 * q_ + 1]); h_[q_] = hp_; \
          l_[q_] = cvt_pk_bf16((V)[2 * q_] - __uint_as_float(hp_ << 16), (V)[2 * q_ + 1] - __uint_as_float(hp_ & 0xffff0000u)); } (HI) = __builtin_bit_cast(bf16x8, h_); (LO) = __builtin_bit_cast(bf16x8, l_); } while (0)
      for (int t = 0; t < 2; ++t) {
          bf16x8 ah[4], al[4];
#pragma unroll
          for (int sk = 0; sk < 4; ++sk) { float v[8];
#pragma unroll
              for (int e = 0; e < 8; ++e) v[e] = ga[(32 * t + li) * 65 + 16 * sk + 8 * lh + e];
              SPLIT8(v, ah[sk], al[sk]); }
          for (int ct = 0; ct < 8; ++ct) { const int ch = 256 * wv + 32 * ct + li;
              bf16x8 bh[4], bl[4]; const float* wp = f_w_out + (size_t)(8 * lh) * D + ch;
#pragma unroll
              for (int sk = 0; sk < 4; ++sk) { float v[8];
#pragma unroll
                  for (int e = 0; e < 8; ++e) v[e] = wp[(size_t)(16 * sk + e) * D];
                  SPLIT8(v, bh[sk], bl[sk]); }
              f32x16 acc0 = {0.f, 0.f, 0.f, 0.f, 0.f, 0.f, 0.f, 0.f, 0.f, 0.f, 0.f, 0.f, 0.f, 0.f, 0.f, 0.f};
#pragma unroll
              for (int sk = 0; sk < 4; ++sk) { acc0 = __builtin_amdgcn_mfma_f32_32x32x16_bf16(al[sk], bh[sk], acc0, 0, 0, 0); acc0 = __builtin_amdgcn_mfma_f32_32x32x16_bf16(ah[sk], bl[sk], acc0, 0, 0, 0); }
#pragma unroll
              for (int sk = 0; sk < 4; ++sk) acc0 = __builtin_amdgcn_mfma_f32_32x32x16_bf16(ah[sk], bh[sk], acc0, 0, 0, 0);
              const float delta = fabsf(-3.070113457325394f + (float)ch * ((-15.350567286626971f + 3.070113457325394f) / 2047.0f));
#pragma unroll
              for (int g = 0; g < 4; ++g) { const int pp = p0 + 32 * t + 8 * g + 4 * lh; f32x4 o;
#pragma unroll
                  for (int e = 0; e < 4; ++e) { const float dist = fabsf((float)(pp + e - Lf / 2)) * invh; o[e] = acc0[4 * g + e] * expf(-dist * delta); }
                  *(f32x4*)(filtT + (size_t)ch * Lf + pp) = o; } } }
#undef SPLIT8
    }
    __syncthreads();
}

__device__ __forceinline__ void modulate_row(const float* src, const float* sh, const float* sc, bf16_t* dst, int lane) {
#pragma unroll
    for (int j = 0; j < 8; ++j) { const int c = lane * 4 + 256 * j; const f32x4 x = *(const f32x4*)(src + c), a = *(const f32x4*)(sc + c), b = *(const f32x4*)(sh + c);
        const f32x4 v = x * (a + 1.0f) + b; u32x2 w; w.x = cvt_pk_bf16(v[0], v[1]); w.y = cvt_pk_bf16(v[2], v[3]); *(u32x2*)(dst + c) = w; }
}
typedef _Float16 h16_t;
typedef _Float16 h16x4 __attribute__((ext_vector_type(4)));
__device__ __forceinline__ f32x4 ld_res4(const float* p) { return __builtin_nontemporal_load((const f32x4*)p); }
__device__ __forceinline__ f32x4 ld_res4(const h16_t* p) { return __builtin_convertvector(__builtin_nontemporal_load((const h16x4*)p), f32x4); }
__device__ __forceinline__ void st_res4(float* p, f32x4 v) { __builtin_nontemporal_store(v, (f32x4*)p); }
__device__ __forceinline__ void st_res4(h16_t* p, f32x4 v) { __builtin_nontemporal_store(__builtin_convertvector(v, h16x4), (h16x4*)p); }
__device__ __forceinline__ f32x4 ldp4(const float* p) { return *(const f32x4*)p; }
__device__ __forceinline__ f32x4 ldp4(const LAS float* p) { return *(const LAS f32x4*)p; }
template <typename RT, typename HT, int NP = 1, typename PP = const float*>
__device__ __forceinline__ void ln_row(const RT* resid, const bf16_t* y, PP gate, PP lg, PP lb, HT* hout, PP sh, PP sc, bf16_t* uout, int lane,
                                       const float* ybias = nullptr) {
    f32x4 z[8]; float s = 0.f;
#pragma unroll
    for (int j = 0; j < 8; ++j) { const int c = lane * 4 + 256 * j; const f32x4 r = ld_res4(resid + c), g = ldp4(gate + c);
        u32x2 yy[NP];
#pragma unroll
        for (int p = 0; p < NP; ++p) yy[p] = *(const u32x2*)(y + (size_t)p * D + c);
        f32x4 yv; yv[0] = __uint_as_float(yy[0].x << 16); yv[1] = __uint_as_float(yy[0].x & 0xffff0000u); yv[2] = __uint_as_float(yy[0].y << 16); yv[3] = __uint_as_float(yy[0].y & 0xffff0000u);
#pragma unroll
        for (int p = 1; p < NP; ++p) { yv[0] += __uint_as_float(yy[p].x << 16); yv[1] += __uint_as_float(yy[p].x & 0xffff0000u); yv[2] += __uint_as_float(yy[p].y << 16); yv[3] += __uint_as_float(yy[p].y & 0xffff0000u); }
        if (NP > 1 && ybias) yv += *(const f32x4*)(ybias + c);
        z[j] = r * ALPHA + g * yv; s += (z[j][0] + z[j][1]) + (z[j][2] + z[j][3]); }
    const float mean = wave_sum(s) * (1.0f / D); float q = 0.f;
#pragma unroll
    for (int j = 0; j < 8; ++j) { z[j] = z[j] - mean; q += (z[j][0] * z[j][0] + z[j][1] * z[j][1]) + (z[j][2] * z[j][2] + z[j][3] * z[j][3]); }
    const float rstd = 1.0f / sqrtf(wave_sum(q) * (1.0f / D) + LN_EPS);
#pragma unroll
    for (int j = 0; j < 8; ++j) { const int c = lane * 4 + 256 * j; const f32x4 g = ldp4(lg + c), b = ldp4(lb + c);
        const f32x4 h = z[j] * rstd * g + b; st_res4(hout + c, h);
        if (uout) { const f32x4 a = ldp4(sc + c), bs = ldp4(sh + c); const f32x4 v = h * (a + 1.0f) + bs;
            u32x2 w; w.x = cvt_pk_bf16(v[0], v[1]); w.y = cvt_pk_bf16(v[2], v[3]); *(u32x2*)(uout + c) = w; } }
}
__device__ __forceinline__ void mla_norm_row(int row, const bf16_t* cqkv, const float* q_norm, const float* kv_norm, const float* rope, bf16_t* cqn, bf16_t* ckvn, bf16_t* krope, int lane) {
    const bf16_t* src = cqkv + (size_t)row * 1280;
#pragma unroll
    for (int part = 0; part < 2; ++part) {
        const u32x4 raw = *(const u32x4*)(src + part * 512 + lane * 8); float x[8];
        x[0] = __uint_as_float(raw.x << 16); x[1] = __uint_as_float(raw.x & 0xffff0000u); x[2] = __uint_as_float(raw.y << 16); x[3] = __uint_as_float(raw.y & 0xffff0000u);
        x[4] = __uint_as_float(raw.z << 16); x[5] = __uint_as_float(raw.z & 0xffff0000u); x[6] = __uint_as_float(raw.w << 16); x[7] = __uint_as_float(raw.w & 0xffff0000u);
        float ss = 0.f;
#pragma unroll
        for (int j = 0; j < 8; ++j) ss += x[j] * x[j];
        const float r = 1.0f / sqrtf(wave_sum(ss) * (1.0f / 512.0f) + RMS_EPS);
        const float* gn = (part == 0 ? q_norm : kv_norm) + lane * 8; const f32x4 g0 = *(const f32x4*)gn, g1 = *(const f32x4*)(gn + 4);
        u32x4 o; o.x = cvt_pk_bf16(x[0] * r * g0[0], x[1] * r * g0[1]); o.y = cvt_pk_bf16(x[2] * r * g0[2], x[3] * r * g0[3]);
        o.z = cvt_pk_bf16(x[4] * r * g1[0], x[5] * r * g1[1]); o.w = cvt_pk_bf16(x[6] * r * g1[2], x[7] * r * g1[3]);
        *(u32x4*)((part == 0 ? cqn : ckvn) + (size_t)row * 512 + lane * 8) = o;
    }
    const float x = bf2f(src[1024 + lane]); const float xp = __shfl_xor(x, 16);
    const int t = row % TB; float outv = x;
    if (t < SEQ) { const int a = lane >> 5, half = (lane >> 4) & 1, p = lane & 15; const int pos = a ? (t & 63) : (t >> 6);
        const f32x2 cs = *(const f32x2*)(rope + (size_t)(pos * 16 + p) * 2);
        outv = half ? (x * cs.x + xp * cs.y) : (x * cs.x - xp * cs.y); }
    krope[(size_t)row * 64 + lane] = f2bf(outv);
}
__device__ __forceinline__ void pool_item(int item, const h16_t* __restrict__ h, const float* __restrict__ sc1, bf16_t* __restrict__ dout) {
    const int cq = item & 511, chunk = (item >> 9) & 127, b = item >> 16;
    const int c = cq * 4, g = c >> 9, hw = 1 << g;
    const h16_t* hb = h + (size_t)b * SEQ * D + c; const float* scp = sc1 + (size_t)b * MODW + c;
    const f32x4 mul = *(const f32x4*)scp + 1.0f;
    const int t0 = chunk * 128;
    f32x4 sum = {0.f, 0.f, 0.f, 0.f};
    for (int tt = t0 - hw; tt < t0 + hw; ++tt) { const int tc = tt < 0 ? 0 : (tt >= SEQ ? SEQ - 1 : tt); const float m = (tt >= 0 && tt < SEQ) ? 1.f : 0.f;
        sum += __builtin_convertvector(*(const h16x4*)(hb + (size_t)tc * D), f32x4) * m; }
    bf16_t* dp = dout + ((size_t)b * TB + t0) * D + c;
    for (int i0 = 0; i0 < 128; i0 += 8) {
        h16x4 cu[8], nx[8], pv[8];
#pragma unroll
        for (int k = 0; k < 8; ++k) { const int t = t0 + i0 + k, tn = (t + hw < SEQ) ? t + hw : SEQ - 1, tp = (t - hw >= 0) ? t - hw : 0;
            cu[k] = *(const h16x4*)(hb + (size_t)t * D); nx[k] = *(const h16x4*)(hb + (size_t)tn * D); pv[k] = *(const h16x4*)(hb + (size_t)tp * D); }
#pragma unroll
        for (int k = 0; k < 8; ++k) { const int t = t0 + i0 + k;
            const int lo = (t - hw) > 0 ? (t - hw) : 0, hi = (t + hw) < SEQ ? (t + hw) : SEQ;
            const f32x4 dv = (sum * (1.0f / (float)(hi - lo)) - __builtin_convertvector(cu[k], f32x4)) * mul;
            u32x2 w; w.x = cvt_pk_bf16(dv[0], dv[1]); w.y = cvt_pk_bf16(dv[2], dv[3]);
            *(u32x2*)(dp + (size_t)(i0 + k) * D) = w;
            const float mn = (t + hw < SEQ) ? 1.f : 0.f, mp = (t - hw >= 0) ? 1.f : 0.f;
            sum += __builtin_convertvector(nx[k], f32x4) * mn - __builtin_convertvector(pv[k], f32x4) * mp; }
    }
}
__device__ __forceinline__ void transpose_tile(const bf16_t* src, bf16_t* dst, int d0, int t0, LAS unsigned* scr, int lane) {
#pragma unroll 8
    for (int i = 0; i < 32; ++i) { const int r = 2 * i + (lane >> 5); scr[r * 33 + (lane & 31)] = *(const unsigned*)(src + (size_t)(d0 + r) * TM + t0 + 2 * (lane & 31)); }
    asm volatile("s_waitcnt lgkmcnt(0)" ::: "memory");
    const LAS bf16_t* s16 = (const LAS bf16_t*)scr;
#pragma unroll 8
    for (int i = 0; i < 32; ++i) { const int tr = 2 * i + (lane >> 5), dp = lane & 31;
        const unsigned lo = s16[(2 * dp) * 66 + tr], hi = s16[(2 * dp + 1) * 66 + tr];
        *(unsigned*)(dst + (size_t)(t0 + tr) * D + d0 + 2 * dp) = lo | (hi << 16); }
    asm volatile("s_waitcnt lgkmcnt(0)" ::: "memory");
}

constexpr size_t MiB = 1u << 20;
constexpr size_t WS_CTL = 0;
constexpr size_t WS_MOD = 1 * MiB;
constexpr size_t WS_ROPE = 2 * MiB;
constexpr size_t WS_FILTC = 3 * MiB;
constexpr size_t WS_HC = 5 * MiB;
constexpr size_t WS_W = 16 * MiB;
constexpr size_t SZ_WGU = (size_t)2 * DFF * D * 2, SZ_WD = (size_t)D * DFF * 2, SZ_HYIN = (size_t)3 * D * D * 2, SZ_DD = (size_t)D * D * 2;
constexpr size_t WS_WGU = WS_W, WS_WD = WS_WGU + 4 * SZ_WGU, WS_HYIN = WS_WD + 4 * SZ_WD, WS_HYOUT = WS_HYIN + 2 * SZ_HYIN;
constexpr size_t WS_MWIN = WS_HYOUT + 2 * SZ_DD, WS_MWQB = WS_MWIN + (size_t)1280 * D * 2, WS_MWKVB = WS_MWQB + (size_t)3072 * 512 * 2, WS_MWOUT = WS_MWKVB + (size_t)4096 * 512 * 2;
constexpr size_t WS_POOLW = WS_MWOUT + SZ_DD, WS_WEND = WS_POOLW + (size_t)D * 512 * 2;
static_assert(WS_WEND == 366 * MiB, "weight region");
constexpr size_t SZ_ROWS = (size_t)TM * D * 2;
constexpr size_t WS_U = 366 * MiB, WS_Y = WS_U + SZ_ROWS, WS_YMIX = WS_Y + SZ_ROWS, WS_FFT = WS_YMIX + SZ_ROWS;
static_assert(SZ_ROWS == 130 * MiB, "row buffer");
constexpr size_t FFT_SCR = (size_t)2 * 32 * 512 * 4;
constexpr size_t WS_BIG = WS_FFT + 256 * FFT_SCR;
constexpr size_t BIG_PROJT = 0, BIG_YT = (size_t)3 * D * TM * 2;
constexpr size_t BIG_MID = 0;
constexpr size_t BIG_CQKV = 0, BIG_CQN = BIG_CQKV + (size_t)TM * 1280 * 2, BIG_CKVN = BIG_CQN + (size_t)TM * 512 * 2, BIG_KROPE = BIG_CKVN + (size_t)TM * 512 * 2;
constexpr size_t BIG_Q = BIG_KROPE + (size_t)TM * 64 * 2, BIG_KV = BIG_Q + (size_t)TM * 3072 * 2, BIG_END = BIG_KV + (size_t)TM * 4096 * 2;
static_assert(BIG_YT + SZ_ROWS <= BIG_END && (size_t)TM * DFF * 2 <= BIG_END, "big region");
constexpr size_t WS_H16 = (WS_BIG + BIG_END + MiB - 1) / MiB * MiB;
constexpr size_t WS_END = WS_H16 + (size_t)NBATCH * SEQ * D * 2;
static_assert(WS_END <= (size_t)1610612736, "workspace budget (4 x largest input = 1.5 GiB)");
static_assert((size_t)D * SEQ * 4 <= SZ_ROWS, "filtT overlays YMIX");

constexpr int LDS_PHASE_BYTES = 150528;  static_assert(att16::SHM_ATTN <= LDS_PHASE_BYTES, "attention LDS");
constexpr int LDS_MISC_OFF = LDS_PHASE_BYTES;
constexpr int LDS_BYTES = 151552;
static_assert(LDS_MISC_OFF + 64 <= LDS_BYTES, "LDS map");

#ifndef FFN_UP_ALIGN
#define FFN_UP_ALIGN true
#endif
#ifndef SHORTK_ALIGN
#define SHORTK_ALIGN true
#endif
#ifndef ATTN_NS
#define ATTN_NS att16
#endif
constexpr int NPHASE = 33;
constexpr int KS_OUT = 8, KS_DOWN = 11;
static_assert((size_t)2 * CTXL * KS_DOWN * D * 2 <= 256 * FFT_SCR && D % (KS_OUT * 128) == 0 && DFF % (KS_DOWN * 128) == 0, "context split-K");
struct Params {
    const float* in[31];
    float* out;
    unsigned char* ws;
    int ph_lo, ph_hi;
    CvtJob jobs[NJOBS];
    int njobs_items, pad;
};

__global__ void __launch_bounds__(512, 2) mega_fwd(Params P) {
    extern __shared__ __attribute__((aligned(16))) unsigned char lds_raw[];
    LAS unsigned char* lds = (LAS unsigned char*)lds_raw;
    const int tid = threadIdx.x, lane = tid & 63, wave = __builtin_amdgcn_readfirstlane(tid >> 6);
    const int G = gridDim.x, bx = blockIdx.x;
    const int vcu = (G % 8 == 0) ? (bx % 8) * (G / 8) + bx / 8 : bx;
    const int gw = vcu * 8 + wave, NGW = G * 8;
    unsigned char* ws = P.ws;
    volatile LAS unsigned* MISC = (volatile LAS unsigned*)(lds + LDS_MISC_OFF);
    if (tid < 16) MISC[tid] = 0u;
    __syncthreads();
    XcdBarrier bar = xcd_barrier_post((unsigned*)(ws + WS_CTL) + 4096, MISC + 8);
    const int lo = P.ph_lo, hi = P.ph_hi;
#define IN(k) (lo <= (k) && (k) < hi)
#ifdef PROBE_BAR2
#define SEAM(k) do { if (IN(k) && IN((k) + 1)) { xcd_barrier(bar); xcd_barrier(bar); } } while (0)
#else
#define SEAM(k) do { if (IN(k) && IN((k) + 1)) xcd_barrier(bar); } while (0)
#endif
#ifndef PROBE_MASK
#define PROBE_MASK 0ull
#endif
#define REP(k) for (int rep_ = 0; rep_ < ((((unsigned long long)(PROBE_MASK) >> (k)) & 1ull) ? 2 : 1); ++rep_)

    const float* x = P.in[0]; const float* cvec = P.in[1]; const float* ctx = P.in[2]; const float* c_ctx = P.in[3];
    const float* ada_w = P.in[4]; const float* ada_b = P.in[5]; const float* ln_g = P.in[6]; const float* ln_b = P.in[7];
    const float* hy_b_in = P.in[12]; const float* hy_conv_w = P.in[13]; const float* hy_conv_b = P.in[14];
    const float* hy_f_w_in = P.in[15]; const float* hy_f_w_hid = P.in[16]; const float* hy_f_b = P.in[17]; const float* hy_f_freq = P.in[18]; const float* hy_f_w_out = P.in[19];
    const float* hy_bias = P.in[20]; const float* hy_b_out = P.in[22];
    const float* mla_q_norm = P.in[24]; const float* mla_kv_norm = P.in[25]; const float* pool_scale = P.in[30];
    float* out = P.out;
    float* mod = (float*)(ws + WS_MOD); float* rope = (float*)(ws + WS_ROPE); float* filtC = (float*)(ws + WS_FILTC); float* HC = (float*)(ws + WS_HC);
    bf16_t* Wgu = (bf16_t*)(ws + WS_WGU); bf16_t* Wd = (bf16_t*)(ws + WS_WD); bf16_t* HyIn = (bf16_t*)(ws + WS_HYIN); bf16_t* HyOut = (bf16_t*)(ws + WS_HYOUT);
    bf16_t* MWin = (bf16_t*)(ws + WS_MWIN); bf16_t* MWqb = (bf16_t*)(ws + WS_MWQB); bf16_t* MWkvb = (bf16_t*)(ws + WS_MWKVB); bf16_t* MWout = (bf16_t*)(ws + WS_MWOUT); bf16_t* PoolW = (bf16_t*)(ws + WS_POOLW);
    bf16_t* U = (bf16_t*)(ws + WS_U); bf16_t* Y = (bf16_t*)(ws + WS_Y); bf16_t* YMIX = (bf16_t*)(ws + WS_YMIX); float* filtT = (float*)(ws + WS_YMIX);
    h16_t* H16 = (h16_t*)(ws + WS_H16);
    float* filtT3 = out;
    unsigned char* big = ws + WS_BIG;
    bf16_t* projT = (bf16_t*)(big + BIG_PROJT); bf16_t* yT = (bf16_t*)(big + BIG_YT); bf16_t* mid = (bf16_t*)(big + BIG_MID);
    bf16_t* cqkv = (bf16_t*)(big + BIG_CQKV); bf16_t* cqn = (bf16_t*)(big + BIG_CQN); bf16_t* ckvn = (bf16_t*)(big + BIG_CKVN); bf16_t* krope = (bf16_t*)(big + BIG_KROPE);
    bf16_t* qbuf = (bf16_t*)(big + BIG_Q); bf16_t* kvbuf = (bf16_t*)(big + BIG_KV);
    unsigned* fftscr = (unsigned*)(ws + WS_FFT + (size_t)bx * FFT_SCR);
    bf16_t* YC = (bf16_t*)(ws + WS_FFT);
#define MODP(layer, r, chunk) (mod + ((size_t)(layer) * 3 + (r)) * MODW + (size_t)(chunk) * D)

#define GEMM_PLAIN_T(ALIGN_, Aptr, lda_, Btptr, ldb_, K_, nM_, nN_, skipM_, skipN_, grp_, Optr, ldc_, biasp, scalep) do { \
        pg8::Gemm g_{(Aptr), (Btptr), (lda_), (ldb_), (K_)}; pg8::Order S_; S_.init((nM_), (nN_), G, bx, (skipM_), (skipN_), (grp_)); \
        pg8::EpiPlain E_{(Optr), (ldc_), (biasp), (scalep)}; pg8::gemm_phase<pg8::EpiPlain, ALIGN_>(lds, g_, S_, E_); } while (0)
#define GEMM_PLAIN(...) GEMM_PLAIN_T(true, __VA_ARGS__)
#define LN_PHASE(layer, which, resid_main, hout_main, resid_ctx, with_ctx, next_u) do { \
        const int gch_ = (which) ? 5 : 2; const int nl_ = (which) ? (layer) + 1 : (layer); const int shc_ = (which) ? 0 : 3; \
        const float* lg_ = ln_g + ((size_t)(layer) * 2 + (which)) * D; const float* lb_ = ln_b + ((size_t)(layer) * 2 + (which)) * D; \
          \
        LAS float* lp_ = (LAS float*)lds; \
        { *(LAS f32x4*)(lp_ + 0 * D + 4 * tid) = *(const f32x4*)(MODP(layer, 0, gch_) + 4 * tid); *(LAS f32x4*)(lp_ + 1 * D + 4 * tid) = *(const f32x4*)(MODP(layer, 1, gch_) + 4 * tid); \
          *(LAS f32x4*)(lp_ + 2 * D + 4 * tid) = *(const f32x4*)(lg_ + 4 * tid); *(LAS f32x4*)(lp_ + 3 * D + 4 * tid) = *(const f32x4*)(lb_ + 4 * tid); \
          if (next_u) { *(LAS f32x4*)(lp_ + 4 * D + 4 * tid) = *(const f32x4*)(MODP(nl_, 0, shc_) + 4 * tid); *(LAS f32x4*)(lp_ + 5 * D + 4 * tid) = *(const f32x4*)(MODP(nl_, 1, shc_) + 4 * tid); \
                        *(LAS f32x4*)(lp_ + 6 * D + 4 * tid) = *(const f32x4*)(MODP(nl_, 0, shc_ + 1) + 4 * tid); *(LAS f32x4*)(lp_ + 7 * D + 4 * tid) = *(const f32x4*)(MODP(nl_, 1, shc_ + 1) + 4 * tid); } } \
        __syncthreads(); \
        for (int row = gw; row < TM; row += NGW) { const int b_ = row / TB, t_ = row % TB; \
            if (t_ < SEQ) { const size_t r_ = (size_t)b_ * SEQ + t_; \
                ln_row<__typeof__(*(resid_main) + 0), __typeof__(*(hout_main) + 0), 1, const LAS float*>((resid_main) + r_ * D, YMIX + (size_t)row * D, lp_ + b_ * D, lp_ + 2 * D, lp_ + 3 * D, (hout_main) + r_ * D, \
                       lp_ + (4 + b_) * D, lp_ + (6 + b_) * D, (next_u) ? U + (size_t)row * D : nullptr, lane); } \
            else if (with_ctx) { const size_t r_ = (size_t)b_ * CTXL + (t_ - SEQ); constexpr int np_ = (which) ? KS_DOWN : KS_OUT; \
                ln_row<float, float, np_, const float*>((resid_ctx) + r_ * D, YC + r_ * (size_t)(np_ * D), MODP(layer, 2, gch_), lg_, lb_, HC + r_ * D, \
                       (next_u) ? MODP(nl_, 2, shc_) : nullptr, (next_u) ? MODP(nl_, 2, shc_ + 1) : nullptr, (next_u) ? U + (size_t)row * D : nullptr, lane, (which) ? nullptr : hy_b_out); } } } while (0)
#define FFN_UP(layer, nM_, skip_) do { pg8::Gemm g_{U, Wgu + (size_t)(layer) * 2 * DFF * D, D, D, D}; pg8::Order S_; S_.init((nM_), 2 * DFF / 256, G, bx, (skip_), 0, 0); \
        pg8::EpiSwiglu E_{mid, DFF}; pg8::gemm_phase<pg8::EpiSwiglu, FFN_UP_ALIGN>(lds, g_, S_, E_); } while (0)
#define FFN_DOWN(layer, nM_, skip_) GEMM_PLAIN(mid, DFF, Wd + (size_t)(layer) * D * DFF, DFF, DFF, (nM_), D / 256, (skip_), 0, 0, YMIX, D, nullptr, nullptr)
#define GEMM_CTX_SPLITK(Aptr, lda_, Btptr, K_, ks_) do { pg8::Gemm g_{(Aptr) + (size_t)SEQ * (lda_), (Btptr), (lda_), (lda_), (K_) / (ks_)}; pg8::Order S_; S_.init_splitk(2, D / 256, (ks_), (K_) / (ks_), TB / 256, G, bx); \
        pg8::EpiPlain E_{YC, (ks_) * D, nullptr, nullptr}; pg8::gemm_phase<pg8::EpiPlain>(lds, g_, S_, E_); } while (0)
#define FILTER_JOBS(j, Lf_, dstp, first_job, njobs_) do { for (int jb_ = bx; jb_ < (njobs_); jb_ += G) \
        filter_job(jb_ + (first_job), (Lf_), hy_f_w_in + (size_t)(j) * 33 * 64, hy_f_w_hid + (size_t)(j) * 2 * 64 * 64, hy_f_b + (size_t)(j) * 192, hy_f_freq + (size_t)(j) * 192, \
                   hy_f_w_out + (size_t)(j) * 64 * D, (dstp), lds, tid); } while (0)
#ifndef FFT_PRIO
#define FFT_PRIO 1
#endif
#if FFT_PRIO
#define FFT_PRIO_ON do { if (wave < 4) __builtin_amdgcn_s_setprio(2); } while (0)
#define FFT_PRIO_OFF __builtin_amdgcn_s_setprio(0)
#else
#define FFT_PRIO_ON do {} while (0)
#define FFT_PRIO_OFF do {} while (0)
#endif
#define HYENA_CONV(j, filtp) do { FFT_PRIO_ON; fft::Tw tw_; fft::tw_init(tw_, tid); float hn_[32]; if (bx < D) { _Pragma("unroll") for (int n1_ = 0; n1_ < 32; ++n1_) hn_[n1_] = (filtp)[(size_t)bx * SEQ + 512 * n1_ + tid]; } \
        for (int d_ = bx; d_ < D; d_ += G) \
        fft::conv_channel(d_, projT, (filtp), hy_b_in + (size_t)(j) * 3 * D, hy_conv_w + (size_t)(j) * 9 * D, hy_conv_b + (size_t)(j) * 3 * D, hy_bias + (size_t)(j) * D, yT, fftscr, lds, tw_, tid, hn_, d_ + G); FFT_PRIO_OFF; } while (0)

    if (IN(0)) REP(0) {
        { LAS unsigned* scr = (LAS unsigned*)(lds + wave * 8448);
          int j = 0; CvtItem cur, nxt; f32x4 va[16], vb[16];
          int it = gw; const int nit = P.njobs_items;
          if (it < nit) { while (j + 1 < NJOBS && it >= P.jobs[j + 1].start) ++j; cvt_locate(P.jobs[j], it - P.jobs[j].start, cur); cvt_load(cur, va, lane); }
          while (it < nit) {
              int it2 = it + NGW; const bool h2 = it2 < nit;
              if (h2) { while (j + 1 < NJOBS && it2 >= P.jobs[j + 1].start) ++j; cvt_locate(P.jobs[j], it2 - P.jobs[j].start, nxt); cvt_load(nxt, vb, lane); }
              cvt_store(cur, va, scr, lane);
              if (!h2) break;
              int it3 = it2 + NGW; const bool h3 = it3 < nit;
              if (h3) { while (j + 1 < NJOBS && it3 >= P.jobs[j + 1].start) ++j; cvt_locate(P.jobs[j], it3 - P.jobs[j].start, cur); cvt_load(cur, va, lane); }
              cvt_store(nxt, vb, scr, lane);
              if (!h3) break;
              it = it3; }
          for (size_t i = (size_t)bx * 512 + tid; i < (size_t)(1280 - 1088) * D / 8; i += (size_t)G * 512) *(u32x4*)(MWin + (size_t)1088 * D + i * 8) = (u32x4){0u, 0u, 0u, 0u}; }
        __syncthreads();
        for (int jb = bx; jb < 256; jb += G) adaln_job(jb, cvec, c_ctx, ada_w, ada_b, mod, lds, tid);
        for (int i = bx * 512 + tid; i < 256 * 16; i += G * 512) { const int pos = i >> 4, p = i & 15; const float inv = powf(10000.0f, -(float)p / 16.0f); const float ang = (float)pos * inv;
            rope[2 * i] = cosf(ang); rope[2 * i + 1] = sinf(ang); }
        __syncthreads();
    }
    SEAM(0);
    if (IN(1)) REP(1) {
        for (int row = gw; row < TM; row += NGW) { const int b = row / TB, t = row % TB;
            if (t < SEQ) modulate_row(x + ((size_t)b * SEQ + t) * D, MODP(0, b, 0), MODP(0, b, 1), U + (size_t)row * D, lane);
            else modulate_row(ctx + ((size_t)b * CTXL + (t - SEQ)) * D, MODP(0, 2, 0), MODP(0, 2, 1), U + (size_t)row * D, lane); }
    }
    SEAM(1);
    if (IN(2)) REP(2) { GEMM_PLAIN(HyIn, D, U, D, D, 3 * D / 256, TM / 256, 0, 0, 0, projT, TM, nullptr, nullptr);
        { const int nwg_ = (3 * D / 256) * (TM / 256), rem_ = nwg_ % G, idle_ = G - rem_, k_ = (bx - rem_ + G) % G;
          if (k_ < idle_) for (int jb_ = k_; jb_ < 260; jb_ += idle_) {
              if (jb_ < 256) filter_job(jb_, SEQ, hy_f_w_in, hy_f_w_hid, hy_f_b, hy_f_freq, hy_f_w_out, filtT, lds, tid);
              else filter_job(jb_ - 256, CTXL, hy_f_w_in, hy_f_w_hid, hy_f_b, hy_f_freq, hy_f_w_out, filtC, lds, tid); } } }
    SEAM(2);
    if (IN(3)) REP(3) { HYENA_CONV(0, filtT);
        { LAS float* wl = (LAS float*)(lds + wave * 3072);
          for (int d = gw; d < D; d += NGW) fft::conv_ctx_channel(d, projT, filtC, hy_b_in, hy_conv_w, hy_conv_b, hy_bias, yT, wl, lane); } }
    SEAM(3);
    if (IN(4)) REP(4) { LAS unsigned* scr = (LAS unsigned*)(lds + wave * 8448);
        for (int tl = gw; tl < (D / 64) * (TM / 64); tl += NGW) transpose_tile(yT, Y, (tl % (D / 64)) * 64, (tl / (D / 64)) * 64, scr, lane); }
    SEAM(4);
    if (IN(5)) REP(5) { GEMM_PLAIN(Y, D, HyOut, D, D, 128, D / 256, 1, 0, 0, YMIX, D, hy_b_out, nullptr); GEMM_CTX_SPLITK(Y, D, HyOut, D, KS_OUT); }
    SEAM(5);
    if (IN(6)) REP(6) LN_PHASE(0, 0, x, H16, ctx, true, true);
    SEAM(6);
    if (IN(7)) REP(7) { FFN_UP(0, TM / 256, 0);
        { const int nwg_ = (TM / 256) * (2 * DFF / 256), rem_ = nwg_ % G, idle_ = G - rem_, k_ = (bx - rem_ + G) % G;
          if (k_ < idle_) for (int jb_ = k_; jb_ < 256; jb_ += idle_)
              filter_job(jb_, SEQ, hy_f_w_in + (size_t)33 * 64, hy_f_w_hid + (size_t)2 * 64 * 64, hy_f_b + 192, hy_f_freq + 192, hy_f_w_out + (size_t)64 * D, filtT3, lds, tid); } }
    SEAM(7);
    if (IN(8)) REP(8) { FFN_DOWN(0, 128, 1); GEMM_CTX_SPLITK(mid, DFF, Wd, DFF, KS_DOWN); }
    SEAM(8);
    if (IN(9)) REP(9) LN_PHASE(0, 1, H16, H16, HC, true, true);
    SEAM(9);
    if (IN(10)) REP(10) GEMM_PLAIN(U, D, MWin, D, D, TM / 256, 1280 / 256, 0, 0, 0, cqkv, 1280, nullptr, nullptr);
    SEAM(10);
    if (IN(11)) REP(11) { for (int row = gw; row < TM; row += NGW) mla_norm_row(row, cqkv, mla_q_norm, mla_kv_norm, rope, cqn, ckvn, krope, lane); }
    SEAM(11);
    if (IN(12)) REP(12) {
        { pg8::Gemm g_{cqn, MWqb, 512, 512, 512}; pg8::Order S_; S_.init(128, 3072 / 256, G, bx, 1, 0, 0); pg8::EpiQRope E_{qbuf, 3072, rope, att16::QSCALE}; pg8::gemm_phase<pg8::EpiQRope, SHORTK_ALIGN>(lds, g_, S_, E_); }
        GEMM_PLAIN_T(SHORTK_ALIGN, ckvn, 512, MWkvb, 512, 512, TM / 256, 4096 / 256, 0, 0, 0, kvbuf, 4096, nullptr, nullptr);
    }
    SEAM(12);
    if (IN(13)) REP(13) {
        for (int u = vcu; u < NBATCH * 16 * 64; u += G) { const int qb = u & 63, h = (u >> 6) & 15, b = u >> 10;
            __syncthreads();
            att16::attn_body(qbuf + ((size_t)b * TB + (size_t)qb * 256) * 3072 + h * 192, kvbuf + (size_t)b * TB * 4096 + h * 256, kvbuf + (size_t)b * TB * 4096 + h * 256 + 128,
                           krope + (size_t)b * TB * 64, Y + ((size_t)b * TB + (size_t)qb * 256) * D + h * 128, TB, (char*)lds_raw); }
    }
    SEAM(13);
    if (IN(14)) REP(14) GEMM_PLAIN(Y, D, MWout, D, D, 128, D / 256, 1, 0, 0, YMIX, D, nullptr, nullptr);
    SEAM(14);
    if (IN(15)) REP(15) LN_PHASE(1, 0, H16, H16, HC, false, true);
    SEAM(15);
    if (IN(16)) REP(16) FFN_UP(1, 128, 1);
    SEAM(16);
    if (IN(17)) REP(17) FFN_DOWN(1, 128, 1);
    SEAM(17);
    if (IN(18)) REP(18) LN_PHASE(1, 1, H16, H16, HC, false, false);
    SEAM(18);
    if (IN(19)) REP(19) { for (int it = bx * 512 + tid; it < NBATCH * 128 * 512; it += G * 512) pool_item(it, H16, MODP(2, 0, 1), Y); }
    SEAM(19);
    if (IN(20)) REP(20) GEMM_PLAIN(Y, D, PoolW, 512, 512, 128, D / 256, 1, 0, 1, YMIX, D, nullptr, pool_scale);
    SEAM(20);
    if (IN(21)) REP(21) LN_PHASE(2, 0, H16, H16, HC, false, true);
    SEAM(21);
    if (IN(22)) REP(22) FFN_UP(2, 128, 1);
    SEAM(22);
    if (IN(23)) REP(23) FFN_DOWN(2, 128, 1);
    SEAM(23);
    if (IN(24)) REP(24) LN_PHASE(2, 1, H16, H16, HC, false, true);
    SEAM(24);
    if (IN(25)) REP(25) { GEMM_PLAIN(HyIn + (size_t)3 * D * D, D, U, D, D, 3 * D / 256, 128, 0, 1, 0, projT, TM, nullptr, nullptr);
    }
    SEAM(25);
    if (IN(26)) REP(26) HYENA_CONV(1, filtT3);
    SEAM(26);
    if (IN(27)) REP(27) { LAS unsigned* scr = (LAS unsigned*)(lds + wave * 8448);
        for (int tl = gw; tl < (D / 64) * (TM / 64); tl += NGW) { const int t0 = (tl / (D / 64)) * 64; if ((t0 % TB) < SEQ) transpose_tile(yT, Y, (tl % (D / 64)) * 64, t0, scr, lane); } }
    SEAM(27);
    if (IN(28)) REP(28) GEMM_PLAIN(Y, D, HyOut + (size_t)D * D, D, D, 128, D / 256, 1, 0, 0, YMIX, D, hy_b_out + D, nullptr);
    SEAM(28);
    if (IN(29)) REP(29) LN_PHASE(3, 0, H16, H16, HC, false, true);
    SEAM(29);
    if (IN(30)) REP(30) FFN_UP(3, 128, 1);
    SEAM(30);
    if (IN(31)) REP(31) FFN_DOWN(3, 128, 1);
    SEAM(31);
    if (IN(32)) REP(32) LN_PHASE(3, 1, H16, out, HC, false, false);
#undef IN
#undef SEAM
}

#ifndef MK_SINGLE
#define MK_SINGLE 1
#endif
extern "C" void kernel_launch(void* const* d_in, const int* in_sizes, int n_in, void* d_out, int out_size, void* d_ws, size_t ws_size, hipStream_t stream) {
    static int grid = 0;
    if (grid == 0) {
        if (n_in != 31 || out_size != NBATCH * SEQ * D || ws_size < WS_END) { fprintf(stderr, "kernel_launch: unexpected problem: n_in %d out %d ws %zu (need %zu)\n", n_in, out_size, ws_size, (size_t)WS_END); grid = -1; return; }
        int dev = 0, cus = 0, per_cu = 0;
        if (hipGetDevice(&dev) != hipSuccess || hipDeviceGetAttribute(&cus, hipDeviceAttributeMultiprocessorCount, dev) != hipSuccess) { grid = -1; return; }
        if (hipFuncSetAttribute((const void*)mega_fwd, hipFuncAttributeMaxDynamicSharedMemorySize, LDS_BYTES) != hipSuccess) { fprintf(stderr, "kernel_launch: hipFuncSetAttribute failed\n"); grid = -1; return; }
        if (hipOccupancyMaxActiveBlocksPerMultiprocessor(&per_cu, (const void*)mega_fwd, 512, LDS_BYTES) != hipSuccess || per_cu < 1) fprintf(stderr, "kernel_launch: occupancy query says %d\n", per_cu);
        (void)hipGetLastError();
        grid = cus < 256 ? cus : 256;
    }
    if (grid < 0) return;
    (void)hipMemsetAsync((char*)d_ws + WS_CTL, 0, 1 * MiB, stream);
    Params P{};
    for (int i = 0; i < 31; ++i) P.in[i] = (const float*)d_in[i];
    P.out = (float*)d_out; P.ws = (unsigned char*)d_ws;
    unsigned char* ws = (unsigned char*)d_ws;
    int nj = 0, items = 0;
    auto add = [&](const float* src, size_t dst_off, int K, int N, int mode) { P.jobs[nj].src = src; P.jobs[nj].dst = (bf16_t*)(ws + dst_off); P.jobs[nj].K = K; P.jobs[nj].N = N; P.jobs[nj].mode = mode; P.jobs[nj].start = items; items += (K / 64) * (N / 64); ++nj; };
    for (int i = 0; i < 4; ++i) {
        add(P.in[8] + (size_t)i * D * DFF, WS_WGU + i * SZ_WGU, D, DFF, 1);
        add(P.in[9] + (size_t)i * D * DFF, WS_WGU + i * SZ_WGU, D, DFF, 2);
        add(P.in[10] + (size_t)i * DFF * D, WS_WD + i * SZ_WD, DFF, D, 0);
    }
    for (int j = 0; j < 2; ++j) { add(P.in[11] + (size_t)j * D * 3 * D, WS_HYIN + j * SZ_HYIN, D, 3 * D, 0); add(P.in[21] + (size_t)j * D * D, WS_HYOUT + j * SZ_DD, D, D, 0); }
    add(P.in[23], WS_MWIN, D, 1088, 0); add(P.in[26], WS_MWQB, 512, 3072, 0); add(P.in[27], WS_MWKVB, 512, 4096, 0); add(P.in[28], WS_MWOUT, D, D, 0);
    for (int g = 0; g < 4; ++g) add(P.in[29] + (size_t)g * 512 * 512, WS_POOLW + (size_t)g * 512 * 512 * 2, 512, 512, 0);
    P.njobs_items = items; P.pad = 0;
#if MK_SINGLE
#ifdef PROBE_EXTRA
    { const int extra[] = {PROBE_EXTRA}; for (int k : extra) { P.ph_lo = k; P.ph_hi = k + 1; hipLaunchKernelGGL(mega_fwd, dim3(grid), dim3(512), LDS_BYTES, stream, P); }
      (void)hipMemsetAsync((char*)d_ws + WS_CTL, 0, 1 * MiB, stream); }
#endif
    P.ph_lo = 0; P.ph_hi = NPHASE;
    hipLaunchKernelGGL(mega_fwd, dim3(grid), dim3(512), LDS_BYTES, stream, P);
#ifdef PROBE_POST
    { const int extra[] = {PROBE_POST}; for (int k : extra) { P.ph_lo = k; P.ph_hi = k + 1; hipLaunchKernelGGL(mega_fwd, dim3(grid), dim3(512), LDS_BYTES, stream, P); } }
#endif
#else
    for (int k = 0; k < NPHASE; ++k) { P.ph_lo = k; P.ph_hi = k + 1; hipLaunchKernelGGL(mega_fwd, dim3(grid), dim3(512), LDS_BYTES, stream, P); }
#endif
    const hipError_t le = hipPeekAtLastError();
    if (le != hipSuccess) fprintf(stderr, "kernel_launch: launch failed: %s\n", hipGetErrorName(le));
}
```
